# Optimizing an MI355X kernel written in HIP

```python
import jax, jax.numpy as jnp
from jax import lax
import numpy as np

D_MODEL = 1024
BATCH = 8
SEQ = 2048
DEPTH = 4
DEC_BATCH = 128
DEC_SEQ = 8
PAST_LEN = 16384
PAGE_SIZE = 128

D_A = D_MODEL // 2
D_B = D_MODEL // 2
CONV_A = 31
CONV_B = 3
D_IN_EVEN = 2 * D_A + 3 * D_B
D_C = D_MODEL
C_HEADS = 8
C_HEAD_DIM = D_C // C_HEADS
CHUNK = 128
D_FF = 4 * D_MODEL
N_EVEN = (DEPTH + 1) // 2
N_ODD = DEPTH // 2
N_MOD = 6
EPS = 1e-6

kernel_name = 'hybrid_conformerconv_shortconv_gmlp_decoder_step'


def rmsnorm(x, g):
    xf = x.astype(jnp.float32)
    y = xf * lax.rsqrt(jnp.mean(xf * xf, axis=-1, keepdims=True) + EPS)
    return (y * g.astype(jnp.float32)).astype(x.dtype)


def layernorm(x, g, b):
    xf = x.astype(jnp.float32)
    mu = jnp.mean(xf, axis=-1, keepdims=True)
    var = jnp.mean(jnp.square(xf - mu), axis=-1, keepdims=True)
    y = (xf - mu) * lax.rsqrt(var + EPS) * g.astype(jnp.float32) + b.astype(jnp.float32)
    return y.astype(x.dtype)


def modulate(x, shift, scale):
    return x * (1 + scale[:, None, :]) + shift[:, None, :]


def causal_dwconv(x_ext, w):
    ch = x_ext.shape[-1]
    return lax.conv_general_dilated(
        x_ext, w[:, None, :].astype(x_ext.dtype), window_strides=(1,), padding='VALID',
        dimension_numbers=('NWC', 'WIO', 'NWC'), feature_group_count=ch)


def even_mixer(h, hist_a, hist_b, w_in, conv_a_w, conv_a_b, ln_a_g, ln_a_b, conv_b_w, w_out):
    z = h @ w_in
    a_val, a_gate, b_x, b_b, b_c = jnp.split(
        z, [D_A, 2 * D_A, 2 * D_A + D_B, 2 * D_A + 2 * D_B], axis=-1)
    a = a_val * jax.nn.sigmoid(a_gate)
    a_ext = jnp.concatenate([hist_a, a], axis=1)
    a = causal_dwconv(a_ext, conv_a_w) + conv_a_b
    a = jax.nn.silu(layernorm(a, ln_a_g, ln_a_b))
    bx = b_c * b_x
    b_ext = jnp.concatenate([hist_b, bx], axis=1)
    b = b_b * causal_dwconv(b_ext, conv_b_w)
    y = jnp.concatenate([a, b], axis=-1) @ w_out
    return y, a_ext[:, -(CONV_A - 1):], b_ext[:, -(CONV_B - 1):]


def odd_mixer(h, w_in, b_in, ln_v_g, ln_v_b, w_s, b_s, w_out):
    n, length, _ = h.shape
    z = jax.nn.gelu(h @ w_in + b_in)
    u, v = jnp.split(z, 2, axis=-1)
    v = layernorm(v, ln_v_g, ln_v_b)
    t = min(length, CHUNK)
    n_chunks = length // t
    mask = jnp.tril(jnp.ones((t, t), dtype=bool))
    ws = jnp.where(mask, w_s[:, :t, :t], 0).astype(v.dtype)
    vc = v.reshape(n, n_chunks, t, C_HEADS, C_HEAD_DIM)
    s = jnp.einsum('hts,bnshd->bnthd', ws, vc) + b_s[:, :t].T[None, None, :, :, None]
    s = s.reshape(n, length, D_C)
    y = (u * s) @ w_out
    return y, v[:, -t:]


def trunk(x, c, hist_a, hist_b, w_in_ab, conv_a_w, conv_a_b, ln_a_g, ln_a_b, conv_b_w, w_out_ab,
          w_in_c, b_in_c, ln_v_g, ln_v_b, w_s, b_s, w_out_c, w_ada, b_ada, norm_g, w_ff1, w_ff2, final_g):
    n = x.shape[0]
    c_act = jax.nn.silu(c)
    new_a, new_b, new_v = [], [], []
    for l in range(DEPTH):
        mod = (c_act @ w_ada[l] + b_ada[l]).reshape(n, N_MOD, D_MODEL)
        sh1, sc1, g1, sh2, sc2, g2 = (mod[:, i] for i in range(N_MOD))
        h = modulate(rmsnorm(x, norm_g[l, 0]), sh1, sc1)
        if l % 2 == 0:
            e = l // 2
            y, sa, sb = even_mixer(h, hist_a[e], hist_b[e], w_in_ab[e], conv_a_w[e], conv_a_b[e],
                                   ln_a_g[e], ln_a_b[e], conv_b_w[e], w_out_ab[e])
            new_a.append(sa)
            new_b.append(sb)
        else:
            o = l // 2
            y, sv = odd_mixer(h, w_in_c[o], b_in_c[o], ln_v_g[o], ln_v_b[o], w_s[o], b_s[o], w_out_c[o])
            new_v.append(sv)
        x = x + g1[:, None, :] * y
        h = modulate(rmsnorm(x, norm_g[l, 1]), sh2, sc2)
        x = x + g2[:, None, :] * (jnp.square(jax.nn.relu(h @ w_ff1[l])) @ w_ff2[l])
    x = rmsnorm(x, final_g)
    return x, jnp.stack(new_a), jnp.stack(new_b), jnp.stack(new_v)


def setup_inputs(seed: int = 0) -> dict:
    key = jax.random.key(seed)
    ks = iter(list(jax.random.split(key, 32)))

    def nrm(shape, scale):
        return jax.random.normal(next(ks), shape, jnp.float32) * scale

    d = D_MODEL
    return {
        'x_prompt': nrm((BATCH, SEQ, d), 1.0),
        'x_sample': nrm((DEC_BATCH, DEC_SEQ, d), 1.0),
        'state_conv_a': nrm((N_EVEN, DEC_BATCH, CONV_A - 1, D_A), 0.5),
        'state_conv_b': nrm((N_EVEN, DEC_BATCH, CONV_B - 1, D_B), 0.5),
        'c_prompt': nrm((BATCH, d), 1.0),
        'c_sample': nrm((DEC_BATCH, d), 1.0),
        'w_in_ab': nrm((N_EVEN, d, D_IN_EVEN), d ** -0.5),
        'conv_a_w': nrm((N_EVEN, CONV_A, D_A), CONV_A ** -0.5),
        'conv_a_b': nrm((N_EVEN, D_A), 0.02),
        'ln_a_g': 1.0 + nrm((N_EVEN, D_A), 0.02),
        'ln_a_b': nrm((N_EVEN, D_A), 0.02),
        'conv_b_w': nrm((N_EVEN, CONV_B, D_B), CONV_B ** -0.5),
        'w_out_ab': nrm((N_EVEN, D_A + D_B, d), (D_A + D_B) ** -0.5),
        'w_in_c': nrm((N_ODD, d, 2 * D_C), d ** -0.5),
        'b_in_c': nrm((N_ODD, 2 * D_C), 0.02),
        'ln_v_g': 1.0 + nrm((N_ODD, D_C), 0.02),
        'ln_v_b': nrm((N_ODD, D_C), 0.02),
        'w_s': nrm((N_ODD, C_HEADS, CHUNK, CHUNK), CHUNK ** -0.5),
        'b_s': 1.0 + nrm((N_ODD, C_HEADS, CHUNK), 0.02),
        'w_out_c': nrm((N_ODD, D_C, d), D_C ** -0.5),
        'w_ada': nrm((DEPTH, d, N_MOD * d), 0.3 * d ** -0.5),
        'b_ada': nrm((DEPTH, N_MOD * d), 0.05),
        'norm_g': 1.0 + nrm((DEPTH, 2, d), 0.02),
        'w_ff1': nrm((DEPTH, d, D_FF), d ** -0.5),
        'w_ff2': nrm((DEPTH, D_FF, d), D_FF ** -0.5),
        'final_g': 1.0 + nrm((d,), 0.02),
    }


def reference(x_prompt, x_sample, state_conv_a, state_conv_b, c_prompt, c_sample,
              w_in_ab, conv_a_w, conv_a_b, ln_a_g, ln_a_b, conv_b_w, w_out_ab,
              w_in_c, b_in_c, ln_v_g, ln_v_b, w_s, b_s, w_out_c,
              w_ada, b_ada, norm_g, w_ff1, w_ff2, final_g):
    weights = (w_in_ab, conv_a_w, conv_a_b, ln_a_g, ln_a_b, conv_b_w, w_out_ab,
               w_in_c, b_in_c, ln_v_g, ln_v_b, w_s, b_s, w_out_c,
               w_ada, b_ada, norm_g, w_ff1, w_ff2, final_g)
    hist_a0 = jnp.zeros((N_EVEN, x_prompt.shape[0], CONV_A - 1, D_A), x_prompt.dtype)
    hist_b0 = jnp.zeros((N_EVEN, x_prompt.shape[0], CONV_B - 1, D_B), x_prompt.dtype)
    y_prompt, conv_a_p, conv_b_p, chunk_v_p = trunk(x_prompt, c_prompt, hist_a0, hist_b0, *weights)
    y_sample, conv_a_s, conv_b_s, chunk_v_s = trunk(
        x_sample, c_sample, state_conv_a.astype(x_sample.dtype), state_conv_b.astype(x_sample.dtype), *weights)
    return (y_prompt, y_sample, conv_a_p, conv_a_s, conv_b_p, conv_b_s, chunk_v_p, chunk_v_s)
```

```cpp
#include <hip/hip_runtime.h>
#include <cstdio>
#include <cstdint>

#ifndef PH_MASK
#define PH_MASK 0xFFFF
#endif
#define PH_ON(b) ((PH_MASK >> (b)) & 1)
#ifndef REP_P
#define REP_P -1
#endif
#ifndef MK_ONE_LAUNCH
#define MK_ONE_LAUNCH 1
#endif

constexpr int DM = 1024, NPROMPT = 8, SEQ = 2048, NSAMP = 128, DSEQ = 8;
constexpr int MP = NPROMPT * SEQ;
constexpr int MS = NSAMP * DSEQ;
constexpr int MT = MP + MS;
constexpr int NSEQ = NPROMPT + NSAMP;
constexpr int DA = 512, DIN_E = 2560, DFF = 4096, NMODL = 6 * DM, NMOD = 4 * NMODL;
constexpr float EPS = 1e-6f;

__device__ __forceinline__ float shfl_xor_l(float v, int mask, int lane) { return __builtin_bit_cast(float, __builtin_amdgcn_ds_bpermute((lane ^ mask) << 2, __builtin_bit_cast(int, v))); }
__device__ __forceinline__ int seq_of_row(int row) { return row < MP ? (row >> 11) : NPROMPT + ((row - MP) >> 3); }

namespace pg8 {
#define PG8_LAS __attribute__((address_space(3)))
typedef unsigned short bf16_t;
typedef short bf16x8 __attribute__((ext_vector_type(8)));
typedef float f32x4 __attribute__((ext_vector_type(4)));
typedef unsigned u32x4 __attribute__((ext_vector_type(4)));
constexpr int BM = 256, BK = 64, HALF = 128, HTB = HALF * BK * 2  , STAGE_BYTES = 8 * HTB, NXCD = 8, WGM = 8;

__host__ __device__ __forceinline__ int lds_byte(int r, int c) { const int st = (r >> 4) * 2 + (c >> 5), rr = r & 15, cc = c & 31, ob = rr * 64 + cc * 2; return st * 1024 + (ob ^ (((ob >> 9) & 1) << 5)); }
__host__ __device__ __forceinline__ void stage_rc(int b, int& R, int& C) { const int st = b / 1024, sb = b % 1024, swz = sb ^ (((sb >> 9) & 1) << 5); R = (st >> 1) * 16 + swz / 64; C = (st & 1) * 32 + (swz % 64) / 2; }
__host__ __device__ __forceinline__ int perm32(int rho) { const int n = rho >> 4, i = rho & 15; return 8 * (i >> 2) + 4 * n + (i & 3); }

struct Unit { int pm, pn; };
struct Gemm { const bf16_t* A; const bf16_t* Bt; const bf16_t* AX; int M, N, K; };

struct StaticOrder {
    int nM, nN, nwg, G, c;
    __host__ __device__ void init(int M, int N, int G_, int c_) { nM = M / BM; nN = N / BM; nwg = nM * nN; G = G_; c = c_; }
    __host__ __device__ bool next(int i, Unit& u) const {
        const long L = (long)i * G + c; if (L >= nwg) return false;
        int wgid = (int)L; { const int q = nwg / NXCD, r = nwg % NXCD, xcd = wgid % NXCD, off = wgid / NXCD; wgid = (xcd < r ? xcd * (q + 1) : r * (q + 1) + (xcd - r) * q) + off; }
        const int nig = WGM * nN, gid = wgid / nig, fm = gid * WGM, gsz = (nM - fm) < WGM ? (nM - fm) : WGM;
        u.pm = fm + ((wgid % nig) % gsz); u.pn = (wgid % nig) / gsz; return true;
    }
    __device__ __forceinline__ void a_ready(const Unit&) const {}
    __device__ __forceinline__ void done(const Unit&) const {}
};

typedef float cvt_f32x2_ __attribute__((ext_vector_type(2)));
typedef __bf16 cvt_bf16x2_ __attribute__((ext_vector_type(2)));
__device__ __forceinline__ unsigned cvt_pk_bf16(float lo, float hi) { const cvt_f32x2_ v = {lo, hi}; return __builtin_bit_cast(unsigned, __builtin_convertvector(v, cvt_bf16x2_)); }
__device__ __forceinline__ float sigmoid_f(float x) { return __builtin_amdgcn_rcpf(1.0f + __expf(-x)); }
__device__ __forceinline__ float gelu_tanh_f(float x) { const float y = 1.5957691216057308f * (x + 0.044715f * x * x * x); return x * sigmoid_f(y); }

struct EpiF32 {
    static constexpr bool PERM = false, AFTER_DRAIN = false;
    float* C; int ldc; const float* bias;
    __device__ __forceinline__ void operator()(const f32x4 (&acc)[2][2][4][2], const f32x4 (&accx)[2], const Unit& u, int wr, int wc, int fr, int fq) const {
        const int row0 = u.pm * BM + wr * 64 + fr, col0 = u.pn * BM + wc * 32 + 4 * fq;
        f32x4 bv[2][2];
#pragma unroll
        for (int bj = 0; bj < 2; ++bj)
#pragma unroll
            for (int n = 0; n < 2; ++n) bv[bj][n] = *(const f32x4*)(bias + col0 + bj * HALF + n * 16);
#pragma unroll
        for (int ai = 0; ai < 2; ++ai)
#pragma unroll
            for (int m = 0; m < 4; ++m) { float* rowp = C + (size_t)(row0 + ai * HALF + m * 16) * ldc + col0;
#pragma unroll
                for (int bj = 0; bj < 2; ++bj)
#pragma unroll
                    for (int n = 0; n < 2; ++n) *(f32x4*)(rowp + bj * HALF + n * 16) = acc[ai][bj][m][n] + bv[bj][n]; }
    }
};
struct EpiResid {
    static constexpr bool PERM = false, AFTER_DRAIN = false;
    const float* xp; const float* xs; float* out; const float* gate;
    __device__ __forceinline__ void operator()(const f32x4 (&acc)[2][2][4][2], const f32x4 (&accx)[2], const Unit& u, int wr, int wc, int fr, int fq) const {
        const int row0 = u.pm * BM + wr * 64 + fr, col0 = u.pn * BM + wc * 32 + 4 * fq;
        {
            const int srow = 16 * u.pm + fr, colx = u.pn * BM + wc * 32 + 16 * wr + 4 * fq;
            const float* src = xs + (size_t)srow * DM + colx; const float* g = gate + (size_t)(NPROMPT + (srow >> 3)) * NMOD + colx; float* dst = out + (size_t)(MP + srow) * DM + colx;
#pragma unroll
            for (int bj = 0; bj < 2; ++bj) { const f32x4 b = *(const f32x4*)(src + bj * HALF), gv = *(const f32x4*)(g + bj * HALF); *(f32x4*)(dst + bj * HALF) = b + gv * accx[bj]; }
        }
#pragma unroll
        for (int ai = 0; ai < 2; ++ai)
#pragma unroll
            for (int m = 0; m < 4; ++m) {
                const int row = row0 + ai * HALF + m * 16;
                const float* src = (row < MP ? xp + (size_t)row * DM : xs + (size_t)(row - MP) * DM) + col0;
                const float* g = gate + (size_t)seq_of_row(row) * NMOD + col0;
                float* dst = out + (size_t)row * DM + col0;
#pragma unroll
                for (int bj = 0; bj < 2; ++bj)
#pragma unroll
                    for (int n = 0; n < 2; ++n) { const f32x4 b = *(const f32x4*)(src + bj * HALF + n * 16), gv = *(const f32x4*)(g + bj * HALF + n * 16);
                        *(f32x4*)(dst + bj * HALF + n * 16) = b + gv * acc[ai][bj][m][n]; }
            }
    }
};
struct EpiRelu2 {
    static constexpr bool PERM = true, AFTER_DRAIN = false;
    bf16_t* O; int ldc;
    __device__ __forceinline__ void operator()(const f32x4 (&acc)[2][2][4][2], const f32x4 (&accx)[2], const Unit& u, int wr, int wc, int fr, int fq) const {
        const int row0 = u.pm * BM + wr * 64 + fr, col0 = u.pn * BM + wc * 32 + 8 * fq;
        {
            bf16_t* rowp = O + (size_t)(MP + 16 * u.pm + fr) * ldc + col0 + 4 * wr;
#pragma unroll
            for (int bj = 0; bj < 2; ++bj) { f32x4 v = __builtin_elementwise_max(accx[bj], (f32x4){0.f, 0.f, 0.f, 0.f}); v = v * v;
                typedef unsigned u32x2v __attribute__((ext_vector_type(2))); *(u32x2v*)(rowp + bj * HALF) = (u32x2v){cvt_pk_bf16(v[0], v[1]), cvt_pk_bf16(v[2], v[3])}; }
        }
#pragma unroll
        for (int ai = 0; ai < 2; ++ai)
#pragma unroll
            for (int m = 0; m < 4; ++m) { bf16_t* rowp = O + (size_t)(row0 + ai * HALF + m * 16) * ldc + col0;
#pragma unroll
                for (int bj = 0; bj < 2; ++bj) { f32x4 v0 = acc[ai][bj][m][0], v1 = acc[ai][bj][m][1];
                    v0 = __builtin_elementwise_max(v0, (f32x4){0.f, 0.f, 0.f, 0.f}); v1 = __builtin_elementwise_max(v1, (f32x4){0.f, 0.f, 0.f, 0.f}); v0 = v0 * v0; v1 = v1 * v1;
                    u32x4 w; w.x = cvt_pk_bf16(v0[0], v0[1]); w.y = cvt_pk_bf16(v0[2], v0[3]); w.z = cvt_pk_bf16(v1[0], v1[1]); w.w = cvt_pk_bf16(v1[2], v1[3]);
                    *(u32x4*)(rowp + bj * HALF) = w; } }
    }
};
struct EpiEvenIn {
    static constexpr bool PERM = true, AFTER_DRAIN = false;
    bf16_t *AG, *BX, *BB;
    __device__ __forceinline__ void operator()(const f32x4 (&acc)[2][2][4][2], const f32x4 (&accx)[2], const Unit& u, int wr, int wc, int fr, int fq) const {
        const int row0 = u.pm * BM + wr * 64 + fr, cw = wc * 32 + 8 * fq;
        {
            typedef unsigned u32x2v __attribute__((ext_vector_type(2)));
            const size_t xrow = (size_t)(MP + 16 * u.pm + fr) * DA; const int cx = cw + 4 * wr;
            if (u.pn < 8) { f32x4 r;
                if (u.pn < 4) {
#pragma unroll
                    for (int i = 0; i < 4; ++i) r[i] = accx[0][i] * sigmoid_f(accx[1][i]);
                } else r = accx[0] * accx[1];
                *(u32x2v*)((u.pn < 4 ? AG : BX) + xrow + 128 * (u.pn & 3) + cx) = (u32x2v){cvt_pk_bf16(r[0], r[1]), cvt_pk_bf16(r[2], r[3])};
            } else {
#pragma unroll
                for (int bj = 0; bj < 2; ++bj) *(u32x2v*)(BB + xrow + 256 * (u.pn - 8) + bj * HALF + cx) = (u32x2v){cvt_pk_bf16(accx[bj][0], accx[bj][1]), cvt_pk_bf16(accx[bj][2], accx[bj][3])};
            }
        }
        if (u.pn < 8) {
            bf16_t* O = (u.pn < 4 ? AG : BX) + 128 * (u.pn & 3) + cw; const bool glu = u.pn < 4;
#pragma unroll
            for (int ai = 0; ai < 2; ++ai)
#pragma unroll
                for (int m = 0; m < 4; ++m) { bf16_t* rowp = O + (size_t)(row0 + ai * HALF + m * 16) * DA;
                    const f32x4 a0 = acc[ai][0][m][0], a1 = acc[ai][0][m][1], g0 = acc[ai][1][m][0], g1 = acc[ai][1][m][1]; f32x4 r0, r1;
                    if (glu) {
#pragma unroll
                        for (int i = 0; i < 4; ++i) { r0[i] = a0[i] * sigmoid_f(g0[i]); r1[i] = a1[i] * sigmoid_f(g1[i]); }
                    } else { r0 = a0 * g0; r1 = a1 * g1; }
                    u32x4 w; w.x = cvt_pk_bf16(r0[0], r0[1]); w.y = cvt_pk_bf16(r0[2], r0[3]); w.z = cvt_pk_bf16(r1[0], r1[1]); w.w = cvt_pk_bf16(r1[2], r1[3]);
                    *(u32x4*)rowp = w; }
        } else {
            bf16_t* O = BB + 256 * (u.pn - 8) + cw;
#pragma unroll
            for (int ai = 0; ai < 2; ++ai)
#pragma unroll
                for (int m = 0; m < 4; ++m) { bf16_t* rowp = O + (size_t)(row0 + ai * HALF + m * 16) * DA;
#pragma unroll
                    for (int bj = 0; bj < 2; ++bj) { const f32x4 v0 = acc[ai][bj][m][0], v1 = acc[ai][bj][m][1];
                        u32x4 w; w.x = cvt_pk_bf16(v0[0], v0[1]); w.y = cvt_pk_bf16(v0[2], v0[3]); w.z = cvt_pk_bf16(v1[0], v1[1]); w.w = cvt_pk_bf16(v1[2], v1[3]);
                        *(u32x4*)(rowp + bj * HALF) = w; } }
        }
    }
};
struct EpiOddIn {
    static constexpr bool PERM = true, AFTER_DRAIN = false;
    bf16_t *U, *V; const float* bias; float* stat;
    __device__ __forceinline__ void operator()(const f32x4 (&acc)[2][2][4][2], const f32x4 (&accx)[2], const Unit& u, int wr, int wc, int fr, int fq) const {
        const int row0 = u.pm * BM + wr * 64 + fr, cw = wc * 32 + 8 * fq, bcol0 = u.pn * BM + cw;
        const bool isv = u.pn >= 4;
        bf16_t* O = (isv ? V + 256 * (u.pn - 4) : U + 256 * u.pn) + cw;
        {
            typedef unsigned u32x2v __attribute__((ext_vector_type(2))); typedef float f32x2v __attribute__((ext_vector_type(2)));
            const int srow = 16 * u.pm + fr; bf16_t* rowp = O + (size_t)(MP + srow) * DM + 4 * wr; float s1 = 0.f, s2 = 0.f;
#pragma unroll
            for (int bj = 0; bj < 2; ++bj) { f32x4 v = accx[bj] + *(const f32x4*)(bias + bcol0 + bj * HALF + 4 * wr);
#pragma unroll
                for (int i = 0; i < 4; ++i) v[i] = gelu_tanh_f(v[i]);
                s1 += (v[0] + v[1]) + (v[2] + v[3]); s2 += (v[0] * v[0] + v[1] * v[1]) + (v[2] * v[2] + v[3] * v[3]);
                *(u32x2v*)(rowp + bj * HALF) = (u32x2v){cvt_pk_bf16(v[0], v[1]), cvt_pk_bf16(v[2], v[3])}; }
            if (isv) { s1 += __shfl_xor(s1, 16); s1 += __shfl_xor(s1, 32); s2 += __shfl_xor(s2, 16); s2 += __shfl_xor(s2, 32);
                if (fq == 0) *(f32x2v*)(stat + (size_t)MP * 32 + ((size_t)srow * 32 + (u.pn - 4) * 8 + wr * 4 + wc) * 2) = (f32x2v){s1, s2}; }
        }
        f32x4 bv[2][2];
#pragma unroll
        for (int bj = 0; bj < 2; ++bj)
#pragma unroll
            for (int n = 0; n < 2; ++n) bv[bj][n] = *(const f32x4*)(bias + bcol0 + bj * HALF + 4 * n);
#pragma unroll
        for (int ai = 0; ai < 2; ++ai)
#pragma unroll
            for (int m = 0; m < 4; ++m) { const int row = row0 + ai * HALF + m * 16; bf16_t* rowp = O + (size_t)row * DM; float s1 = 0.f, s2 = 0.f;
#pragma unroll
                for (int bj = 0; bj < 2; ++bj) { f32x4 v0 = acc[ai][bj][m][0] + bv[bj][0], v1 = acc[ai][bj][m][1] + bv[bj][1];
#pragma unroll
                    for (int i = 0; i < 4; ++i) { v0[i] = gelu_tanh_f(v0[i]); v1[i] = gelu_tanh_f(v1[i]); }
                    s1 += (v0[0] + v0[1]) + (v0[2] + v0[3]) + (v1[0] + v1[1]) + (v1[2] + v1[3]);
                    s2 += (v0[0] * v0[0] + v0[1] * v0[1]) + (v0[2] * v0[2] + v0[3] * v0[3]) + (v1[0] * v1[0] + v1[1] * v1[1]) + (v1[2] * v1[2] + v1[3] * v1[3]);
                    u32x4 w; w.x = cvt_pk_bf16(v0[0], v0[1]); w.y = cvt_pk_bf16(v0[2], v0[3]); w.z = cvt_pk_bf16(v1[0], v1[1]); w.w = cvt_pk_bf16(v1[2], v1[3]);
                    *(u32x4*)(rowp + bj * HALF) = w; }
                if (isv) { s1 += __shfl_xor(s1, 16); s1 += __shfl_xor(s1, 32); s2 += __shfl_xor(s2, 16); s2 += __shfl_xor(s2, 32);
                    if (fq == 0) { typedef float f32x2v __attribute__((ext_vector_type(2))); *(f32x2v*)(stat + ((size_t)row * 16 + (u.pn - 4) * 4 + wc) * 2) = (f32x2v){s1, s2}; } }
            }
    }
};

struct EpiBBconv {
    static constexpr bool PERM = true;
    const bf16_t* BX; bf16_t* AB; const float* cw; const float* hist;
    __device__ __forceinline__ static f32x4 bf4(unsigned a, unsigned b) { return (f32x4){__builtin_bit_cast(float, a << 16), __builtin_bit_cast(float, a & 0xffff0000u), __builtin_bit_cast(float, b << 16), __builtin_bit_cast(float, b & 0xffff0000u)}; }
    __device__ __forceinline__ void operator()(const f32x4 (&acc)[2][2][4][2], const f32x4 (&accx)[2], const Unit& u, int wr, int wc, int fr_in, int fq) const {
        typedef unsigned u32x2v __attribute__((ext_vector_type(2)));
        const int cwv = u.pn * BM + wc * 32 + 8 * fq;
        {   const int fr = fr_in;
            const int srow = 16 * u.pm + fr, t = srow & 7, sq = srow >> 3;
#pragma unroll
            for (int bj = 0; bj < 2; ++bj) { const int c = cwv + bj * HALF + 4 * wr;
                const f32x4 w0 = *(const f32x4*)(cw + c), w1 = *(const f32x4*)(cw + DA + c), w2 = *(const f32x4*)(cw + 2 * DA + c);
                const u32x2v x2 = *(const u32x2v*)(BX + (size_t)(MP + srow) * DA + c), x1 = *(const u32x2v*)(BX + (size_t)(MP + srow - (t >= 1 ? 1 : 0)) * DA + c), x0 = *(const u32x2v*)(BX + (size_t)(MP + srow - (t >= 2 ? 2 : 0)) * DA + c);
                const f32x4 h1 = *(const f32x4*)(hist + ((size_t)sq * 2 + 1) * DA + c), h0 = *(const f32x4*)(hist + ((size_t)sq * 2 + (t >= 1 ? 1 : 0)) * DA + c);
                const f32x4 b2 = bf4(x2.x, x2.y), b1 = t >= 1 ? bf4(x1.x, x1.y) : h1, b0 = t >= 2 ? bf4(x0.x, x0.y) : h0;
                const f32x4 o = accx[bj] * (w0 * b0 + w1 * b1 + w2 * b2);
                *(u32x2v*)(AB + (size_t)(MP + srow) * DM + DA + c) = (u32x2v){cvt_pk_bf16(o[0], o[1]), cvt_pk_bf16(o[2], o[3])}; }
        }
#pragma unroll
        for (int bj = 0; bj < 2; ++bj) { const int c = cwv + bj * HALF;
            f32x4 w[3][2];
#pragma unroll
            for (int k = 0; k < 3; ++k) { w[k][0] = *(const f32x4*)(cw + k * DA + c); w[k][1] = *(const f32x4*)(cw + k * DA + c + 4); }
#pragma unroll
            for (int am = 0; am < 4; ++am) { const int ai = am >> 1, mb = (am & 1) * 2;
                int fr = fr_in; asm volatile("" : "+v"(fr));
                u32x4 xr[2][3];
#pragma unroll
                for (int mm = 0; mm < 2; ++mm) { const int row = u.pm * BM + ai * HALF + wr * 64 + (mb + mm) * 16 + fr, t = row & (SEQ - 1);
#pragma unroll
                    for (int d = 0; d < 3; ++d) xr[mm][d] = *(const u32x4*)(BX + (size_t)(row - (t >= d ? d : 0)) * DA + c); }
#pragma unroll
                for (int mm = 0; mm < 2; ++mm) { const int m = mb + mm, row = u.pm * BM + ai * HALF + wr * 64 + m * 16 + fr, t = row & (SEQ - 1);
                    const f32x4 z = (f32x4){0.f, 0.f, 0.f, 0.f};
                    const f32x4 b2l = bf4(xr[mm][0].x, xr[mm][0].y), b2h = bf4(xr[mm][0].z, xr[mm][0].w);
                    const f32x4 b1l = t >= 1 ? bf4(xr[mm][1].x, xr[mm][1].y) : z, b1h = t >= 1 ? bf4(xr[mm][1].z, xr[mm][1].w) : z;
                    const f32x4 b0l = t >= 2 ? bf4(xr[mm][2].x, xr[mm][2].y) : z, b0h = t >= 2 ? bf4(xr[mm][2].z, xr[mm][2].w) : z;
                    const f32x4 ol = acc[ai][bj][m][0] * (w[0][0] * b0l + w[1][0] * b1l + w[2][0] * b2l), oh = acc[ai][bj][m][1] * (w[0][1] * b0h + w[1][1] * b1h + w[2][1] * b2h);
                    *(u32x4*)(AB + (size_t)row * DM + DA + c) = (u32x4){cvt_pk_bf16(ol[0], ol[1]), cvt_pk_bf16(ol[2], ol[3]), cvt_pk_bf16(oh[0], oh[1]), cvt_pk_bf16(oh[2], oh[3])}; }
                asm volatile("" ::: "memory"); }
        }
    }
};
struct EpiResidNorm {
    static constexpr bool PERM = true;
    const void* xp; const void* xs; void* out; const float* gate;
    bf16_t* H; const float* ng; const float* msh; float* xbuf; unsigned* cnt; bool fin, xf32; float* rn; unsigned epoch;
    typedef unsigned u32x2v_ __attribute__((ext_vector_type(2)));
    __device__ __forceinline__ static float inv_scale(float d) { return __builtin_amdgcn_rcpf(__builtin_copysignf(__builtin_fmaxf(__builtin_fabsf(d), 0x1p-12f), d)); }
    __device__ __forceinline__ static f32x4 bf4(unsigned a, unsigned b) { return (f32x4){__builtin_bit_cast(float, a << 16), __builtin_bit_cast(float, a & 0xffff0000u), __builtin_bit_cast(float, b << 16), __builtin_bit_cast(float, b & 0xffff0000u)}; }
    __device__ __forceinline__ void ld8(const void* base, size_t off, f32x4& lo, f32x4& hi) const {
        if (xf32) { lo = *(const f32x4*)((const float*)base + off); hi = *(const f32x4*)((const float*)base + off + 4); }
        else { const u32x4 w = *(const u32x4*)((const bf16_t*)base + off); lo = bf4(w.x, w.y); hi = bf4(w.z, w.w); }
    }
    __device__ __forceinline__ f32x4 ld4(const void* base, size_t off) const {
        if (xf32) return *(const f32x4*)((const float*)base + off);
        const u32x2v_ w = *(const u32x2v_*)((const bf16_t*)base + off); return bf4(w.x, w.y);
    }
    __device__ __forceinline__ void fused(f32x4 (&acc)[2][2][4][2], f32x4 (&accx)[2], const Unit& u, int wr, int wc, int fr, int fq, PG8_LAS unsigned char* lds, int wid, int lane) const {
        PG8_LAS float* P = (PG8_LAS float*)lds;
        PG8_LAS float* PX = (PG8_LAS float*)(lds + 4096);
        PG8_LAS float* S = (PG8_LAS float*)(lds + 4096 + 512);
        const int col0 = u.pn * BM + wc * 32 + 8 * fq, colx = col0 + 4 * wr, tid = wid * 64 + lane;
        f32x4 gvm[2][2];
#pragma unroll
        for (int bj = 0; bj < 2; ++bj)
#pragma unroll
            for (int n = 0; n < 2; ++n) gvm[bj][n] = *(const f32x4*)(gate + (size_t)(u.pm >> 3) * NMOD + col0 + bj * HALF + n * 4);
#pragma unroll
        for (int ai = 0; ai < 2; ++ai)
#pragma unroll
            for (int bj = 0; bj < 2; ++bj)
#pragma unroll
                for (int m = 0; m < 4; ++m) { acc[ai][bj][m][0] = acc[ai][bj][m][0] * gvm[bj][0]; acc[ai][bj][m][1] = acc[ai][bj][m][1] * gvm[bj][1]; }
        asm volatile("" ::: "memory");
        f32x4 ivp[2][2], shp[2][2];
        { const float* shr = (const float*)xs + (size_t)(u.pm >> 3) * NMOD + col0;
#pragma unroll
            for (int bj = 0; bj < 2; ++bj)
#pragma unroll
                for (int n = 0; n < 2; ++n) { const int c = bj * HALF + n * 4; const f32x4 gp = *(const f32x4*)((const float*)xp + col0 + c), sc = *(const f32x4*)(shr + DM + c); shp[bj][n] = *(const f32x4*)(shr + c);
                    const f32x4 d = gp * (sc + 1.0f); ivp[bj][n] = (f32x4){inv_scale(d[0]), inv_scale(d[1]), inv_scale(d[2]), inv_scale(d[3])}; } }
#pragma unroll
        for (int am = 0; am < 4; ++am) { const int ai = am >> 1, mb = (am & 1) * 2;
            int frb = fr; asm volatile("" : "+v"(frb));
            u32x4 xr[2][2]; float rnp[2];
#pragma unroll
            for (int mm = 0; mm < 2; ++mm) { const int row = u.pm * BM + ai * HALF + wr * 64 + (mb + mm) * 16 + frb; rnp[mm] = rn[row];
#pragma unroll
                for (int bj = 0; bj < 2; ++bj) xr[mm][bj] = *(const u32x4*)(H + (size_t)row * DM + col0 + bj * HALF); }
#pragma unroll
            for (int mm = 0; mm < 2; ++mm) { const int m = mb + mm, r = ai * HALF + wr * 64 + m * 16 + frb; float ss = 0.f;
#pragma unroll
                for (int bj = 0; bj < 2; ++bj) {
                    const f32x4 b0 = (bf4(xr[mm][bj].x, xr[mm][bj].y) - shp[bj][0]) * ivp[bj][0] * rnp[mm], b1 = (bf4(xr[mm][bj].z, xr[mm][bj].w) - shp[bj][1]) * ivp[bj][1] * rnp[mm];
                    const f32x4 x0 = b0 + acc[ai][bj][m][0], x1 = b1 + acc[ai][bj][m][1]; acc[ai][bj][m][0] = x0; acc[ai][bj][m][1] = x1;
                    ss += (x0[0] * x0[0] + x0[1] * x0[1]) + (x0[2] * x0[2] + x0[3] * x0[3]) + (x1[0] * x1[0] + x1[1] * x1[1]) + (x1[2] * x1[2] + x1[3] * x1[3]); }
                ss += __shfl_xor(ss, 16); ss += __shfl_xor(ss, 32);
                if (fq == 0) P[r * 4 + wc] = ss; }
            asm volatile("" ::: "memory");
        }
        { const int srow = 16 * u.pm + fr; const size_t xo = (size_t)srow * DM + colx; const float* g = gate + (size_t)(NPROMPT + (srow >> 3)) * NMOD + colx; float ss = 0.f;
#pragma unroll
            for (int bj = 0; bj < 2; ++bj) { f32x4 b; const f32x4 gv = *(const f32x4*)(g + bj * HALF);
                { const float* shr = (const float*)xs + (size_t)(NPROMPT + (srow >> 3)) * NMOD + colx + bj * HALF; const u32x2v_ w = *(const u32x2v_*)(H + (size_t)MP * DM + xo + bj * HALF);
                    const f32x4 d = *(const f32x4*)((const float*)xp + colx + bj * HALF) * (*(const f32x4*)(shr + DM) + 1.0f);
                    b = (bf4(w.x, w.y) - *(const f32x4*)shr) * (f32x4){inv_scale(d[0]), inv_scale(d[1]), inv_scale(d[2]), inv_scale(d[3])} * rn[MP + srow]; }
                const f32x4 xn = b + gv * accx[bj]; accx[bj] = xn; ss += (xn[0] * xn[0] + xn[1] * xn[1]) + (xn[2] * xn[2] + xn[3] * xn[3]); }
            ss += __shfl_xor(ss, 16); ss += __shfl_xor(ss, 32);
            if (fq == 0) PX[fr * 8 + wid] = ss; }
        asm volatile("s_waitcnt lgkmcnt(0)" ::: "memory"); __builtin_amdgcn_s_barrier(); asm volatile("" ::: "memory");
        typedef __attribute__((address_space(1))) unsigned long long gu64_;
        gu64_* const gran = (gu64_*)xbuf + (size_t)u.pm * 272 * 4;
        if (tid < 272) { float tot;
            if (tid < 256) tot = (P[tid * 4 + 0] + P[tid * 4 + 1]) + (P[tid * 4 + 2] + P[tid * 4 + 3]);
            else { const PG8_LAS float* q = PX + (tid - 256) * 8; tot = ((q[0] + q[1]) + (q[2] + q[3])) + ((q[4] + q[5]) + (q[6] + q[7])); }
            __hip_atomic_store(gran + tid * 4 + u.pn, ((unsigned long long)epoch << 32) | __builtin_bit_cast(unsigned, tot), __ATOMIC_RELAXED, __HIP_MEMORY_SCOPE_AGENT); }
        typedef unsigned u32x2v __attribute__((ext_vector_type(2)));
        f32x4 ggm[2][2], svm[2][2], cvm[2][2];
        { const float* sh = msh + (size_t)(u.pm >> 3) * NMOD + col0;
#pragma unroll
            for (int bj = 0; bj < 2; ++bj)
#pragma unroll
                for (int n = 0; n < 2; ++n) { const int c = bj * HALF + n * 4; ggm[bj][n] = *(const f32x4*)(ng + col0 + c); svm[bj][n] = *(const f32x4*)(sh + c); cvm[bj][n] = *(const f32x4*)(sh + DM + c) + 1.0f; } }
        if (wid < 5) { const int rr = tid < 272 ? tid : 271; float pv[4];
            for (unsigned spins = 0;;) { bool ok = true;
#pragma unroll
                for (int k = 0; k < 4; ++k) { const unsigned long long x = __hip_atomic_load(gran + rr * 4 + k, __ATOMIC_RELAXED, __HIP_MEMORY_SCOPE_AGENT); pv[k] = __builtin_bit_cast(float, (unsigned)x); ok &= (unsigned)(x >> 32) == epoch; }
                if (__all(ok)) break;
                if (++spins > (1u << 20)) break;
                __builtin_amdgcn_s_sleep(1); }
            if (tid < 272) { const float ms = ((pv[0] + pv[1]) + (pv[2] + pv[3])) * (1.0f / DM) + EPS, rs = 1.0f / sqrtf(ms); S[tid] = rs;
                if (u.pn == 0 && !fin) rn[tid < 256 ? u.pm * BM + tid : MP + 16 * u.pm + (tid - 256)] = ms * rs; } }
        asm volatile("s_waitcnt lgkmcnt(0)" ::: "memory"); __builtin_amdgcn_s_barrier(); asm volatile("" ::: "memory");
#pragma unroll
        for (int ai = 0; ai < 2; ++ai)
#pragma unroll
            for (int m = 0; m < 4; ++m) { const int r = ai * HALF + wr * 64 + m * 16 + fr, row = u.pm * BM + r; const float rstd = S[r];
                float* dst = (float*)out + (size_t)row * DM + col0; bf16_t* hp = H + (size_t)row * DM + col0;
#pragma unroll
                for (int bj = 0; bj < 2; ++bj) { const f32x4 x0 = acc[ai][bj][m][0], x1 = acc[ai][bj][m][1];
                    if (fin) { *(f32x4*)(dst + bj * HALF) = x0 * rstd * ggm[bj][0]; *(f32x4*)(dst + bj * HALF + 4) = x1 * rstd * ggm[bj][1]; }
                    else { const f32x4 h0 = x0 * rstd * ggm[bj][0] * cvm[bj][0] + svm[bj][0], h1 = x1 * rstd * ggm[bj][1] * cvm[bj][1] + svm[bj][1];
                        *(u32x4*)(hp + bj * HALF) = (u32x4){cvt_pk_bf16(h0[0], h0[1]), cvt_pk_bf16(h0[2], h0[3]), cvt_pk_bf16(h1[0], h1[1]), cvt_pk_bf16(h1[2], h1[3])}; } } }
        { const int srow = 16 * u.pm + fr; const float rstd = S[256 + fr];
            const float* sh = msh + (size_t)(NPROMPT + (srow >> 3)) * NMOD + colx; float* dst = (float*)out + (size_t)(MP + srow) * DM + colx; bf16_t* hp = H + (size_t)(MP + srow) * DM + colx;
#pragma unroll
            for (int bj = 0; bj < 2; ++bj) { const int c = bj * HALF; const f32x4 xn = accx[bj]; const f32x4 gg = *(const f32x4*)(ng + colx + c);
                if (fin) *(f32x4*)(dst + c) = xn * rstd * gg;
                else { const f32x4 sv = *(const f32x4*)(sh + c), cv = *(const f32x4*)(sh + DM + c); const f32x4 h = xn * rstd * gg * (cv + 1.0f) + sv;
                    *(u32x2v*)(hp + c) = (u32x2v){cvt_pk_bf16(h[0], h[1]), cvt_pk_bf16(h[2], h[3])}; } } }
    }
};
struct EpiAny {
    static constexpr bool AFTER_DRAIN = false;
    int kind; bool perm; int ldc;
    void *p0, *p1, *p2; const float *f0, *f1, *f2; float* f3; const float *f4, *f5;
    __device__ __forceinline__ void fused(f32x4 (&acc)[2][2][4][2], f32x4 (&accx)[2], const Unit& u, int wr, int wc, int fr, int fq, PG8_LAS unsigned char* lds, int wid, int lane) const {
        EpiResidNorm e{(const void*)f0, (const void*)f1, (void*)f3, f2, (bf16_t*)p0, f4, f5, (float*)p1, (unsigned*)p2, (ldc & 1) != 0, (ldc & 2) != 0, (float*)p1 + (5u << 17), (unsigned)(ldc >> 8) + 1u};
        e.fused(acc, accx, u, wr, wc, fr, fq, lds, wid, lane);
    }
    __device__ __forceinline__ void operator()(const f32x4 (&acc)[2][2][4][2], const f32x4 (&accx)[2], const Unit& u, int wr, int wc, int fr, int fq) const {
        switch (kind) {
            case 0: { EpiF32 e{(float*)p0, ldc, f0}; e(acc, accx, u, wr, wc, fr, fq); } break;
            case 1: { EpiEvenIn e{(bf16_t*)p0, (bf16_t*)p1, (bf16_t*)p2}; e(acc, accx, u, wr, wc, fr, fq); } break;
            case 2: { EpiOddIn e{(bf16_t*)p0, (bf16_t*)p1, f0, f3}; e(acc, accx, u, wr, wc, fr, fq); } break;
            case 3: break;
            case 5: { EpiBBconv e{(const bf16_t*)p1, (bf16_t*)p0, f0, f1}; e(acc, accx, u, wr, wc, fr, fq); } break;
            default: { EpiRelu2 e{(bf16_t*)p0, ldc}; e(acc, accx, u, wr, wc, fr, fq); } break;
        }
    }
};

template <class Epi, class Sched, bool ALIGN_EPI = false, bool SP2 = true>
__device__ __forceinline__ void gemm_phase(PG8_LAS unsigned char* lds, const Gemm g, const Sched& S, const Epi& E) {
    static_assert(SP2, "only the two-super-phase loop is kept");
    int tid_ = threadIdx.x; asm volatile("" : "+v"(tid_));
    const int tid = tid_, wid = __builtin_amdgcn_readfirstlane(tid >> 6), lane = tid & 63, wr = wid >> 2, wc = wid & 3, fr = lane & 15, fq = lane >> 4;
    const int K = g.K, nt = K / BK;
    unsigned voffA, voffB;
    { int R, C; stage_rc(tid * 16, R, C); const int Rb = E.perm ? ((R & ~31) + perm32(R & 31)) : R;
        voffA = (unsigned)(R * K + C) * 2u; voffB = (unsigned)(Rb * K + C) * 2u; }
    const size_t rstep64 = (size_t)64 * K * 2;
    const unsigned voffX = (unsigned)((tid >> 5) * K) * 2u + (unsigned)((((tid & 31) >> 2) ^ ((tid >> 6) & 7)) * 16 + (tid & 3) * 4);
    const size_t kstep = (size_t)(BK * 2);
    const size_t hstep = (size_t)HALF * K * 2;
    const size_t tstep = 2 * hstep;
    const size_t xstep = (size_t)16 * K * 2;
    const unsigned ldsw = (unsigned)wid * 1024u;
    const unsigned ldswx = (unsigned)wid * 256u;
    const int aoff = lds_byte(wr * 64 + fr, fq * 8), boff = lds_byte(wc * 32 + fr, fq * 8), xoff = fr * 128 + ((fq ^ (fr >> 1)) << 4);
#define PG8_SA(b, h) (((b) * 2 + (h)) * HTB)
#define PG8_SB(b, h) ((4 + (b) * 2 + (h)) * HTB)
#define PG8_SX(b) (STAGE_BYTES + (b) * 2048)
#define PG8_STAGE(bufoff, gbase, voff) do { _Pragma("unroll") for (int _i = 0; _i < 2; ++_i) { const char* _p = (const char*)(gbase) + (size_t)_i * rstep64; asm volatile("" : "+s"(_p)); \
        __builtin_amdgcn_global_load_lds((const unsigned*)(_p + (voff)), (PG8_LAS unsigned*)(lds + (bufoff) + ldsw + _i * 8192), 16, 0, 0); } } while (0)
#define PG8_STAGEX(b, gbase) do { const char* _p = (const char*)(gbase); asm volatile("" : "+s"(_p)); \
        __builtin_amdgcn_global_load_lds((const unsigned*)(_p + voffX), (PG8_LAS unsigned*)(lds + PG8_SX(b) + ldswx), 4, 0, 0); } while (0)
#define PG8_LDA(dst, b, h) do { _Pragma("unroll") for (int m = 0; m < 4; ++m) _Pragma("unroll") for (int k = 0; k < 2; ++k) dst[m][k] = *(const PG8_LAS bf16x8*)(lds + PG8_SA(b, h) + aoff + m * 2048 + k * 1024); } while (0)
#define PG8_LDB(dst, b, h) do { _Pragma("unroll") for (int n = 0; n < 2; ++n) _Pragma("unroll") for (int k = 0; k < 2; ++k) dst[n][k] = *(const PG8_LAS bf16x8*)(lds + PG8_SB(b, h) + boff + n * 2048 + k * 1024); } while (0)
#define PG8_LDX(dst, b) do { _Pragma("unroll") for (int k = 0; k < 2; ++k) dst[k] = *(const PG8_LAS bf16x8*)(lds + PG8_SX(b) + (xoff ^ (k * 64))); } while (0)
#define PG8_MMA(ai, bj, At, Bt) do { __builtin_amdgcn_s_setprio(1); _Pragma("unroll") for (int m = 0; m < 4; ++m) _Pragma("unroll") for (int n = 0; n < 2; ++n) _Pragma("unroll") for (int k = 0; k < 2; ++k) \
        acc[ai][bj][m][n] = __builtin_amdgcn_mfma_f32_16x16x32_bf16(Bt[n][k], At[m][k], acc[ai][bj][m][n], 0, 0, 0); __builtin_amdgcn_s_setprio(0); } while (0)
#define PG8_MMAX(Xt) do { if (wr == 0) { _Pragma("unroll") for (int k = 0; k < 2; ++k) { accx[0] = __builtin_amdgcn_mfma_f32_16x16x32_bf16(B0[0][k], Xt[k], accx[0], 0, 0, 0); accx[1] = __builtin_amdgcn_mfma_f32_16x16x32_bf16(B1[0][k], Xt[k], accx[1], 0, 0, 0); } } \
        else { _Pragma("unroll") for (int k = 0; k < 2; ++k) { accx[0] = __builtin_amdgcn_mfma_f32_16x16x32_bf16(B0[1][k], Xt[k], accx[0], 0, 0, 0); accx[1] = __builtin_amdgcn_mfma_f32_16x16x32_bf16(B1[1][k], Xt[k], accx[1], 0, 0, 0); } } } while (0)
#define PG8_WAIT_V(n) asm volatile("s_waitcnt vmcnt(" #n ")" ::: "memory")
#define PG8_WAIT_L(n) asm volatile("s_waitcnt lgkmcnt(" #n ")" ::: "memory")
#define PG8_BAR __builtin_amdgcn_s_barrier()
#define PG8_SCHED __builtin_amdgcn_sched_barrier(0)
    Unit cur, nxt; int ui = 0;
    if (!S.next(0, cur)) return;
    f32x4 acc[2][2][4][2]; f32x4 accx[2];
#pragma unroll
    for (int a = 0; a < 2; ++a)
#pragma unroll
        for (int b = 0; b < 2; ++b)
#pragma unroll
            for (int m = 0; m < 4; ++m)
#pragma unroll
                for (int n = 0; n < 2; ++n) acc[a][b][m][n] = (f32x4){0.f, 0.f, 0.f, 0.f};
    accx[0] = (f32x4){0.f, 0.f, 0.f, 0.f}; accx[1] = (f32x4){0.f, 0.f, 0.f, 0.f};
    bf16x8 At[4][2], B0[2][2], B1[2][2], Xt[2];
    const char* cA = (const char*)g.A + (size_t)cur.pm * tstep; const char* cB = (const char*)g.Bt + (size_t)cur.pn * tstep; const char* cX = (const char*)g.AX + (size_t)cur.pm * xstep;
    S.a_ready(cur);
    PG8_STAGE(PG8_SB(0, 0), cB, voffB); PG8_STAGE(PG8_SB(0, 1), cB + hstep, voffB); PG8_STAGE(PG8_SA(0, 0), cA, voffA); PG8_STAGE(PG8_SA(0, 1), cA + hstep, voffA); PG8_STAGEX(0, cX);
    if (wr == 1) PG8_BAR;
    PG8_WAIT_V(3); PG8_BAR;
    PG8_STAGE(PG8_SB(1, 0), cB + kstep, voffB); PG8_STAGE(PG8_SA(1, 0), cA + kstep, voffA); PG8_STAGE(PG8_SB(1, 1), cB + hstep + kstep, voffB);
    PG8_WAIT_V(6); PG8_BAR;
    for (;;) {
        const bool has_next = S.next(ui + 1, nxt);
        const char* nA = has_next ? (const char*)g.A + (size_t)nxt.pm * tstep : cA; const char* nB = has_next ? (const char*)g.Bt + (size_t)nxt.pn * tstep : cB;
        const char* nX = has_next ? (const char*)g.AX + (size_t)nxt.pm * xstep : cX;
        for (int t = 0; t < nt; t += 2) {
            const bool last = (t == nt - 2);
            const bool relax = (t == 0) && (ui > 0) && (E.kind == 4);
            const char* a1 = cA + (size_t)(t + 1) * kstep; const char* x1 = cX + (size_t)(t + 1) * kstep;
            const char* a2 = last ? nA : cA + (size_t)(t + 2) * kstep; const char* b2 = last ? nB : cB + (size_t)(t + 2) * kstep;
            const char* x2 = last ? nX : cX + (size_t)(t + 2) * kstep;
            const char* a3 = a2 + kstep; const char* b3 = b2 + kstep;
            if (last && has_next) S.a_ready(nxt);
            PG8_LDB(B0, 0, 0); PG8_LDB(B1, 0, 1); PG8_SCHED; PG8_LDA(At, 0, 0); PG8_STAGE(PG8_SA(1, 1), a1 + hstep, voffA); PG8_STAGEX(1, x1);
            if (relax) PG8_WAIT_V(27); else PG8_WAIT_V(9);
            PG8_WAIT_L(0); PG8_BAR; PG8_MMA(0, 0, At, B0); PG8_MMA(0, 1, At, B1); PG8_BAR; PG8_SCHED;
            PG8_LDA(At, 0, 1); PG8_LDX(Xt, 0); PG8_STAGE(PG8_SB(0, 0), b2, voffB); PG8_STAGE(PG8_SB(0, 1), b2 + hstep, voffB); PG8_STAGE(PG8_SA(0, 0), a2, voffA);
            if (relax) PG8_WAIT_V(27); else PG8_WAIT_V(9);
            PG8_WAIT_L(0); PG8_BAR; PG8_MMA(1, 0, At, B0); PG8_MMA(1, 1, At, B1); PG8_MMAX(Xt); PG8_BAR; PG8_SCHED;
            PG8_LDB(B0, 1, 0); PG8_LDB(B1, 1, 1); PG8_SCHED; PG8_LDA(At, 1, 0); PG8_STAGE(PG8_SA(0, 1), a2 + hstep, voffA); PG8_STAGEX(0, x2);
            PG8_WAIT_V(9); PG8_WAIT_L(0); PG8_BAR; PG8_MMA(0, 0, At, B0); PG8_MMA(0, 1, At, B1); PG8_BAR; PG8_SCHED;
            PG8_LDA(At, 1, 1); PG8_LDX(Xt, 1); PG8_STAGE(PG8_SB(1, 0), b3, voffB); PG8_STAGE(PG8_SB(1, 1), b3 + hstep, voffB); PG8_STAGE(PG8_SA(1, 0), a3, voffA);
            PG8_WAIT_V(9); PG8_WAIT_L(0); PG8_BAR; PG8_MMA(1, 0, At, B0); PG8_MMA(1, 1, At, B1); PG8_MMAX(Xt); PG8_BAR; PG8_SCHED;
        }
        if constexpr (ALIGN_EPI) { if (wr == 0) PG8_BAR; }
        { int fr_ = fr, fq_ = fq; asm volatile("" : "+v"(fr_), "+v"(fq_));
          if (E.kind != 3) E(acc, accx, cur, wr, wc, fr_, fq_); } S.done(cur);
        if (!has_next) break;
#pragma unroll
        for (int a = 0; a < 2; ++a)
#pragma unroll
            for (int b = 0; b < 2; ++b)
#pragma unroll
                for (int m = 0; m < 4; ++m)
#pragma unroll
                    for (int n = 0; n < 2; ++n) acc[a][b][m][n] = (f32x4){0.f, 0.f, 0.f, 0.f};
        accx[0] = (f32x4){0.f, 0.f, 0.f, 0.f}; accx[1] = (f32x4){0.f, 0.f, 0.f, 0.f};
        cur = nxt; cA = nA; cB = nB; cX = nX; ++ui;
        if constexpr (ALIGN_EPI) { if (wr == 1) PG8_BAR; }
    }
    PG8_WAIT_V(0);
    if constexpr (!ALIGN_EPI) { if (wr == 0) PG8_BAR; }
    PG8_BAR;
    if (E.kind == 3) { int fr_ = fr, fq_ = fq, ln_ = lane; asm volatile("" : "+v"(fr_), "+v"(fq_), "+v"(ln_)); E.fused(acc, accx, cur, wr, wc, fr_, fq_, lds, wid, ln_); }
#undef PG8_SA
#undef PG8_SB
#undef PG8_SX
#undef PG8_STAGE
#undef PG8_STAGEX
#undef PG8_LDA
#undef PG8_LDB
#undef PG8_LDX
#undef PG8_MMA
#undef PG8_MMAX
#undef PG8_WAIT_V
#undef PG8_WAIT_L
#undef PG8_BAR
#undef PG8_SCHED
}
}
#ifndef PG8_SP2
#define PG8_SP2 true
#endif
#ifndef PG8_ALIGN
#define PG8_ALIGN true
#endif

constexpr int NWAVES = 8;
constexpr int N_PHASES = 23;

constexpr size_t OUT_Y = 0;
constexpr size_t OUT_CA_P = (size_t)MT * DM;
constexpr size_t OUT_CA_S = OUT_CA_P + 2 * 8 * 30 * 512;
constexpr size_t OUT_CB_P = OUT_CA_S + 2 * 128 * 30 * 512;
constexpr size_t OUT_CB_S = OUT_CB_P + 2 * 8 * 2 * 512;
constexpr size_t OUT_CV_P = OUT_CB_S + 2 * 128 * 2 * 512;
constexpr size_t OUT_CV_S = OUT_CV_P + 2 * 8 * 128 * 1024;
constexpr size_t OUT_END = OUT_CV_S + 2 * 128 * 8 * 1024;
static_assert(OUT_END == 26476544, "d_out map");

constexpr size_t MiB = 1u << 20;
constexpr size_t WS_CTL = 0, CTL_ZERO_BYTES = 256 * 1024;
constexpr size_t WS_WINAB = 2 * MiB;
constexpr size_t WS_WOUTAB = 12 * MiB;
constexpr size_t WS_WINC = 16 * MiB;
constexpr size_t WS_WOUTC = 24 * MiB;
constexpr size_t WS_WFF1 = 28 * MiB;
constexpr size_t WS_WFF2 = 60 * MiB;
constexpr size_t WS_WADA = 92 * MiB;
constexpr size_t WS_CACT = 140 * MiB;
constexpr size_t WS_MOD = 141 * MiB;
constexpr size_t WS_STAT = 165 * MiB;
constexpr size_t WS_H = 168 * MiB;
constexpr size_t WS_BIG = 202 * MiB;
constexpr size_t WS_XBUF = 338 * MiB;
constexpr size_t WS_XB = 341 * MiB;
constexpr size_t WS_END = 375 * MiB;
constexpr size_t BIG_AG = 0, BIG_BX = 17 * MiB, BIG_BB = 34 * MiB, BIG_AB = 51 * MiB;
constexpr size_t BIG_U = 0, BIG_V = 34 * MiB, BIG_US = 68 * MiB;
static_assert((size_t)MT * DFF * 2 == 136 * MiB && (size_t)MT * DM * 2 == 34 * MiB && (size_t)MT * 512 * 2 == 17 * MiB, "sizes");
constexpr int CW_BAR = 1024;
constexpr int CW_SEAM = 8192;
static_assert((CW_SEAM + 8 * 64 * 64) * 4 <= (int)CTL_ZERO_BYTES, "CTL words inside the memset region");

constexpr int RING_OFF = 0, RING_BYTES = 131072;
constexpr int SLAB_BYTES = 4096;
constexpr int LDSCTL_OFF = RING_BYTES + SLAB_BYTES, MISC_OFF = LDSCTL_OFF + 320;
constexpr int LDS_BYTES = 147456;

#define GAS __attribute__((address_space(1)))
#define LAS __attribute__((address_space(3)))
typedef unsigned short bf16;
typedef unsigned v4u __attribute__((ext_vector_type(4)));
typedef unsigned v2u __attribute__((ext_vector_type(2)));
typedef float f32x4 __attribute__((ext_vector_type(4)));
typedef float f32x2 __attribute__((ext_vector_type(2)));
typedef short bf16x8 __attribute__((ext_vector_type(8)));
typedef GAS unsigned gu32;
#define RLX_AGENT __ATOMIC_RELAXED, __HIP_MEMORY_SCOPE_AGENT
#define LDS_WAIT() asm volatile("s_waitcnt lgkmcnt(0)" ::: "memory")
#define VM_WAIT() asm volatile("s_waitcnt vmcnt(0)" ::: "memory")
__device__ __forceinline__ unsigned f2bf(float f) { unsigned u = __builtin_bit_cast(unsigned, f); return (u + 0x7fffu + ((u >> 16) & 1u)) >> 16; }
__device__ __forceinline__ unsigned pk2(float lo, float hi) { return pg8::cvt_pk_bf16(lo, hi); }
__device__ __forceinline__ float bf2f(unsigned short b) { return __builtin_bit_cast(float, (unsigned)b << 16); }
__device__ __forceinline__ float bflo(unsigned w) { return __builtin_bit_cast(float, w << 16); }
__device__ __forceinline__ float bfhi(unsigned w) { return __builtin_bit_cast(float, w & 0xffff0000u); }
__device__ __forceinline__ float silu_f(float x) { return x * __builtin_amdgcn_rcpf(1.0f + __expf(-x)); }

#define XB_TMO      128
#define XB_XCNT(j)  (256  + 64 * (j))
#define XB_XSUB(j)  (1280 + 64 * (j))
#define XB_XGEN(j)  (2304 + 64 * (j))
#define XB_TOP      3328
#define XB_TOPGEN   3392
#define XCD_BAR_WORDS 3456
#define XB_SPIN_CAP (1u << 18)

__device__ __forceinline__ unsigned xb_ld(unsigned* p)              { return __hip_atomic_load(p, __ATOMIC_RELAXED, __HIP_MEMORY_SCOPE_AGENT); }
__device__ __forceinline__ unsigned xb_add(unsigned* p, unsigned v) { return __hip_atomic_fetch_add(p, v, __ATOMIC_RELAXED, __HIP_MEMORY_SCOPE_AGENT); }
__device__ __forceinline__ unsigned xb_xcc_id() { return (unsigned)__builtin_amdgcn_s_getreg((3 << 11) | 20) & 0xFu; }
#define XB_SPIN(cond, bar) do { unsigned _sp = 0; while (cond) { __builtin_amdgcn_s_sleep(1); \
    if ((++_sp & 255u) == 0u) { if (xb_ld(&(bar)[XB_TMO])) break; if (_sp > XB_SPIN_CAP) { atomicAdd(&(bar)[XB_TMO], 1u); break; } } } } while (0)

struct XcdBarrier {
    unsigned* bar; unsigned x;
    volatile LAS unsigned* st;
};

__device__ __forceinline__ XcdBarrier xcd_barrier_post(unsigned* bar, volatile LAS unsigned* st) {
    XcdBarrier b; b.bar = bar; b.x = xb_xcc_id(); b.st = st;
    if (threadIdx.x == 0) (void)xb_add(&bar[XB_XCNT(b.x)], 1u);
    return b;
}
__device__ __forceinline__ void xcd_barrier_complete(unsigned* bar, unsigned x, unsigned& nloc, unsigned& nx) {
    const unsigned G = gridDim.x * gridDim.y * gridDim.z;
    unsigned sum, cnt, mine, sp = 0u;
    for (;;) {
        sum = 0u; cnt = 0u; mine = 0u;
#pragma unroll
        for (unsigned j = 0; j < 16; ++j) { const unsigned c = xb_ld(&bar[XB_XCNT(j)]); sum += c; cnt += (c > 0u) ? 1u : 0u; mine = (j == x) ? c : mine; }
        if (sum == G) break;
        __builtin_amdgcn_s_sleep(1);
        if ((++sp & 255u) == 0u) { if (xb_ld(&bar[XB_TMO])) break; if (sp > XB_SPIN_CAP) { atomicAdd(&bar[XB_TMO], 1u); break; } }
    }
    nloc = mine > 0u ? mine : 1u; nx = cnt > 0u ? cnt : 1u;
}

__device__ __forceinline__ void xcd_barrier(const XcdBarrier& b) {
    asm volatile("s_waitcnt vmcnt(0)" ::: "memory");
    __syncthreads();
    if (threadIdx.x == 0) {
        unsigned* bar = b.bar;
        __builtin_amdgcn_s_waitcnt(0);
        unsigned nloc = b.st[0], nx = b.st[1];
        if (nloc == 0u) { xcd_barrier_complete(bar, b.x, nloc, nx); b.st[0] = nloc; b.st[1] = nx; }
        const unsigned old = xb_add(&bar[XB_XSUB(b.x)], 1u);
        const unsigned gen = old / nloc;
        if (old + 1u == (gen + 1u) * nloc) {
            __builtin_amdgcn_fence(__ATOMIC_RELEASE, "agent");
            asm volatile("s_waitcnt vmcnt(0)" ::: "memory");
            const unsigned og = xb_add(&bar[XB_TOP], 1u);
            const unsigned tg = og / nx;
            if (og + 1u == (tg + 1u) * nx) xb_add(&bar[XB_TOPGEN], 1u);
            else XB_SPIN(xb_ld(&bar[XB_TOPGEN]) == tg, bar);
            __builtin_amdgcn_fence(__ATOMIC_ACQUIRE, "agent");
            xb_add(&bar[XB_XGEN(b.x)], 1u);
            asm volatile("s_waitcnt vmcnt(0)" ::: "memory");
        } else {
            XB_SPIN(xb_ld(&bar[XB_XGEN(b.x)]) == gen, bar);
            __builtin_amdgcn_fence(__ATOMIC_ACQUIRE, "agent");
            asm volatile("s_waitcnt vmcnt(0)" ::: "memory");
        }
    }
    __syncthreads();
}
struct Args { const float* in[26]; float* out; unsigned char* ws; int ph_lo, ph_hi, li, pad; };
#define INP(i) (args.in[(i) + F.z])
struct Frame {
    LAS unsigned char* lds;
    volatile LAS unsigned* MISC;
    gu32* ctl;
    int tid, lane, wave, G, bid;
    int z;
    float* out;
    unsigned char* ws;
};
__device__ __forceinline__ float wave_sum(float v, int lane) {
    (void)lane;
#pragma unroll
    for (int o = 1; o < 64; o <<= 1) v += __shfl_xor(v, o);
    return v;
}

__device__ __forceinline__ void p0_transpose_item(const float* W, int K, int N, bf16* WT, int k0, int n0, int drow0, LAS float* scr, int lane) {
    f32x4 v[8];
#pragma unroll
    for (int i = 0; i < 8; ++i) { const int q = lane + 64 * i; v[i] = __builtin_nontemporal_load((const f32x4*)(W + (size_t)(k0 + (q >> 3)) * N + n0 + 4 * (q & 7))); }
#pragma unroll
    for (int i = 0; i < 8; ++i) { const int q = lane + 64 * i; LAS float* d = scr + (q >> 3) * 33 + 4 * (q & 7); d[0] = v[i].x; d[1] = v[i].y; d[2] = v[i].z; d[3] = v[i].w; }
    LDS_WAIT(); asm volatile("" ::: "memory");
    const int c = lane & 7;
#pragma unroll
    for (int j = 0; j < 4; ++j) { const int n = (lane >> 3) + 8 * j; const LAS float* s = scr + (8 * c) * 33 + n;
        v4u o; o.x = pk2(s[0 * 33], s[1 * 33]); o.y = pk2(s[2 * 33], s[3 * 33]); o.z = pk2(s[4 * 33], s[5 * 33]); o.w = pk2(s[6 * 33], s[7 * 33]);
        *(GAS v4u*)(WT + (size_t)(drow0 + n) * K + k0 + 8 * c) = o; }
    LDS_WAIT(); asm volatile("" ::: "memory");
}
__device__ __forceinline__ int even_in_row(int c) {
    const int seg = c >> 9, r = c & 511, q = r >> 7, j = r & 127;
    if (seg == 0) return 256 * q + j;
    if (seg == 1) return 256 * q + 128 + j;
    if (seg == 2) return 1024 + 256 * q + j;
    if (seg == 4) return 1024 + 256 * q + 128 + j;
    return 2048 + r;
}
template <bool DEFERRED>
__device__ __forceinline__ void p0_items(Frame& F, const Args& args, int gw, int NGW) {
    LAS float* scr = (LAS float*)(F.lds + RING_OFF + F.wave * 16384);
    constexpr int I_INAB = 16 * 80, I_OUT = 16 * 32, I_INC = 16 * 64, I_FF1 = 16 * 128, I_FF2 = 64 * 32, I_ADA = 16 * 192;
    constexpr int T0 = 0, T1 = T0 + 2 * I_INAB, T2 = T1 + 2 * I_OUT, T3 = T2 + 2 * I_INC, T4 = T3 + 2 * I_OUT, T5 = T4 + 4 * I_FF1, T6 = T5 + 4 * I_FF2, T7 = T6 + 4 * I_ADA;
    constexpr int NDEF = T7 - 13 * 2048, D0 = T6 - NDEF;
    for (int i = gw; i < (DEFERRED ? NDEF : T7 - NDEF); i += NGW) {
        int it;
        if (DEFERRED) it = D0 + i;
        else { constexpr int NADA = T7 - T6, NFF1 = D0 - T4; it = i < NADA ? T6 + i : (i - NADA < NFF1 ? T4 + (i - NADA) : i - NADA - NFF1); }
        const float* W; bf16* WT; int K, N, r, per; bool perm = false;
        if (it < T1)      { r = it - T0; per = I_INAB; K = 1024; N = 2560; W = INP(6);  WT = (bf16*)(F.ws + WS_WINAB);  perm = true; }
        else if (it < T2) { r = it - T1; per = I_OUT;  K = 1024; N = 1024; W = INP(12); WT = (bf16*)(F.ws + WS_WOUTAB); }
        else if (it < T3) { r = it - T2; per = I_INC;  K = 1024; N = 2048; W = INP(13); WT = (bf16*)(F.ws + WS_WINC); }
        else if (it < T4) { r = it - T3; per = I_OUT;  K = 1024; N = 1024; W = INP(19); WT = (bf16*)(F.ws + WS_WOUTC); }
        else if (it < T5) { r = it - T4; per = I_FF1;  K = 1024; N = 4096; W = INP(23); WT = (bf16*)(F.ws + WS_WFF1); }
        else if (it < T6) { r = it - T5; per = I_FF2;  K = 4096; N = 1024; W = INP(24); WT = (bf16*)(F.ws + WS_WFF2); }
        else              { r = it - T6; per = I_ADA;  K = 1024; N = 6144; W = INP(20); WT = (bf16*)(F.ws + WS_WADA); }
        const int layer = r / per, item = r % per; W += (size_t)layer * K * N; WT += (size_t)layer * K * N;
        const int nblk = N / 32, kb = item / nblk, nb = item % nblk, k0 = 64 * kb, n0 = 32 * nb;
        p0_transpose_item(W, K, N, WT, k0, n0, perm ? even_in_row(n0) : n0, scr, F.lane);
    }
}
__device__ __forceinline__ void p0_prologue(Frame& F, const Args& args) {
    { unsigned long long* gz = (unsigned long long*)(F.ws + WS_XBUF);
      for (int i = F.bid * (NWAVES * 64) + F.tid; i < 64 * 272 * 4; i += F.G * NWAVES * 64) gz[i] = 0ull; }
    p0_items<false>(F, args, F.bid * NWAVES + F.wave, F.G * NWAVES);
    bf16* cact = (bf16*)(F.ws + WS_CACT);
    for (int idx = F.bid * (NWAVES * 64) + F.tid; idx < 256 * DM; idx += F.G * NWAVES * 64) {
        const int row = idx >> 10, col = idx & 1023; float v = 0.f;
        if (row < NPROMPT) v = silu_f(INP(4)[row * DM + col]); else if (row < NSEQ) v = silu_f(INP(5)[(row - NPROMPT) * DM + col]);
        cact[idx] = (bf16)f2bf(v);
    }
}

__device__ __forceinline__ void norm_phase(Frame& F, const Args& args, const float* xp, const float* xs, const float* g, const float* msh, const float* msc, bf16* H) {
    const int gw = F.bid * NWAVES + F.wave, NGW = F.G * NWAVES;
    const GAS f32x4* g4 = (const GAS f32x4*)g + F.lane;
    for (int row = gw; row < MT; row += NGW) {
        const float* src = row < MP ? xp + (size_t)row * DM : xs + (size_t)(row - MP) * DM;
        const GAS f32x4* xr = (const GAS f32x4*)src + F.lane;
        const int sq = seq_of_row(row);
        const GAS f32x4* sh4 = (const GAS f32x4*)(msh + (size_t)sq * NMOD) + F.lane; const GAS f32x4* sc4 = (const GAS f32x4*)(msc + (size_t)sq * NMOD) + F.lane;
        f32x4 v[4]; float ss = 0.f;
#pragma unroll
        for (int j = 0; j < 4; ++j) { v[j] = __builtin_nontemporal_load(xr + (j >> 1) * 128 + F.lane + (j & 1)); ss += (v[j].x * v[j].x + v[j].y * v[j].y) + (v[j].z * v[j].z + v[j].w * v[j].w); }
        const float ms0 = wave_sum(ss, F.lane) * (1.0f / DM) + EPS, rstd = 1.0f / sqrtf(ms0);
        if (F.lane == 0) ((float*)(F.ws + WS_XBUF) + (5u << 17))[row] = ms0 * rstd;
        f32x4 h[4];
#pragma unroll
        for (int j = 0; j < 4; ++j) { const int o4 = (j >> 1) * 128 + F.lane + (j & 1); const f32x4 gg = g4[o4], sc = sc4[o4], sh = sh4[o4]; h[j] = v[j] * rstd * gg * (sc + 1.0f) + sh; }
        GAS v4u* o16 = (GAS v4u*)(H + (size_t)row * DM) + F.lane;
        o16[0] = (v4u){pk2(h[0].x, h[0].y), pk2(h[0].z, h[0].w), pk2(h[1].x, h[1].y), pk2(h[1].z, h[1].w)};
        o16[64] = (v4u){pk2(h[2].x, h[2].y), pk2(h[2].z, h[2].w), pk2(h[3].x, h[3].y), pk2(h[3].z, h[3].w)};
    }
}
__device__ __forceinline__ void final_norm_phase(Frame& F, const Args& args, float* x, const float* g) {
    const int gw = F.bid * NWAVES + F.wave, NGW = F.G * NWAVES;
    const GAS f32x4* g4 = (const GAS f32x4*)g + F.lane;
    for (int row = gw; row < MT; row += NGW) {
        GAS f32x4* xr = (GAS f32x4*)(x + (size_t)row * DM) + F.lane;
        f32x4 v[4]; float ss = 0.f;
#pragma unroll
        for (int j = 0; j < 4; ++j) { v[j] = xr[64 * j]; ss += (v[j].x * v[j].x + v[j].y * v[j].y) + (v[j].z * v[j].z + v[j].w * v[j].w); }
        const float rstd = 1.0f / sqrtf(wave_sum(ss, F.lane) * (1.0f / DM) + EPS);
#pragma unroll
        for (int j = 0; j < 4; ++j) xr[64 * j] = v[j] * rstd * g4[64 * j];
    }
}

template <int R, bool SAMPLE>
__device__ __forceinline__ void even_prep_item(Frame& F, const Args& args, int e, int rowbase, int t0, int sidx) {
    const bf16* AG = (const bf16*)(F.ws + WS_BIG + BIG_AG); const bf16* BX = (const bf16*)(F.ws + WS_BIG + BIG_BX);
    bf16* AB = (bf16*)(F.ws + WS_BIG + BIG_AB);
    LAS float* CO = (LAS float*)(F.lds + RING_OFF);
    const int c = F.tid;
    const f32x4 g0 = *(const f32x4*)(INP(9) + e * DA + 4 * F.lane), g1 = *(const f32x4*)(INP(9) + e * DA + 256 + 4 * F.lane);
    const f32x4 b0 = *(const f32x4*)(INP(10) + e * DA + 4 * F.lane), b1 = *(const f32x4*)(INP(10) + e * DA + 256 + 4 * F.lane);
    float bx[R + 2];
    if (SAMPLE) {
        const float* st = INP(3) + ((size_t)(e * NSAMP + sidx) * 2) * DA + c;
        bx[0] = st[0]; bx[1] = st[DA];
#pragma unroll
        for (int j = 0; j < R; ++j) bx[2 + j] = bf2f(BX[(size_t)(rowbase + j) * DA + c]);
    } else {
#pragma unroll
        for (int j = 0; j < R + 2; ++j) { const int t = t0 - 2 + j; const int rr = rowbase - 2 + j + (t < 0 ? -t : 0);
            const float v = bf2f(BX[(size_t)rr * DA + c]); bx[j] = t < 0 ? 0.f : v; }
    }
    {
        float in[R + 30];
        if (SAMPLE) {
            const float* st = INP(2) + ((size_t)(e * NSAMP + sidx) * 30) * DA + c;
#pragma unroll
            for (int j = 0; j < 30; ++j) in[j] = st[(size_t)j * DA];
#pragma unroll
            for (int j = 0; j < R; ++j) in[30 + j] = bf2f(AG[(size_t)(rowbase + j) * DA + c]);
        } else {
#pragma unroll
            for (int j = 0; j < R + 30; ++j) { const int t = t0 - 30 + j; const int rr = rowbase - 30 + j + (t < 0 ? -t : 0);
                const float v = bf2f(AG[(size_t)rr * DA + c]); in[j] = t < 0 ? 0.f : v; }
        }
        float w[31];
#pragma unroll
        for (int k = 0; k < 31; ++k) w[k] = INP(7)[(size_t)(e * 31 + k) * DA + c];
        const float bias = INP(8)[e * DA + c];
#pragma unroll
        for (int t = 0; t < R; ++t) { float a = bias;
#pragma unroll
            for (int k = 0; k < 31; ++k) a = fmaf(w[k], in[t + k], a);
            CO[t * DA + c] = a; }
        if (SAMPLE) { float* o = F.out + OUT_CA_S + ((size_t)(e * NSAMP + sidx) * 30) * DA + c;
#pragma unroll
            for (int j = 0; j < 30; ++j) o[(size_t)j * DA] = in[R + j];
        } else if (t0 == SEQ - R) { float* o = F.out + OUT_CA_P + ((size_t)(e * NPROMPT + sidx) * 30) * DA + c;
#pragma unroll
            for (int j = 0; j < 30; ++j) o[(size_t)j * DA] = in[R + j]; }
    }
    __syncthreads();
    {
        for (int t = F.wave; t < R; t += NWAVES) {
            const f32x4 x0 = *(const LAS f32x4*)(CO + t * DA + 4 * F.lane), x1 = *(const LAS f32x4*)(CO + t * DA + 256 + 4 * F.lane);
            const float mean = wave_sum((x0.x + x0.y) + (x0.z + x0.w) + (x1.x + x1.y) + (x1.z + x1.w), F.lane) * (1.0f / DA);
            const f32x4 d0 = x0 - mean, d1 = x1 - mean;
            const float var = wave_sum((d0.x * d0.x + d0.y * d0.y) + (d0.z * d0.z + d0.w * d0.w) + (d1.x * d1.x + d1.y * d1.y) + (d1.z * d1.z + d1.w * d1.w), F.lane) * (1.0f / DA);
            const float rstd = 1.0f / sqrtf(var + EPS);
            f32x4 y0 = d0 * rstd * g0 + b0, y1 = d1 * rstd * g1 + b1;
#pragma unroll
            for (int i = 0; i < 4; ++i) { y0[i] = silu_f(y0[i]); y1[i] = silu_f(y1[i]); }
            bf16* o = AB + (size_t)(rowbase + t) * DM + 4 * F.lane;
            *(GAS v2u*)o = (v2u){pk2(y0.x, y0.y), pk2(y0.z, y0.w)}; *(GAS v2u*)(o + 256) = (v2u){pk2(y1.x, y1.y), pk2(y1.z, y1.w)};
        }
    }
    {
        if (SAMPLE) { float* o = F.out + OUT_CB_S + ((size_t)(e * NSAMP + sidx) * 2) * DA + c; o[0] = bx[R]; o[DA] = bx[R + 1]; }
        else if (t0 == SEQ - R) { float* o = F.out + OUT_CB_P + ((size_t)(e * NPROMPT + sidx) * 2) * DA + c; o[0] = bx[R]; o[DA] = bx[R + 1]; }
    }
    __syncthreads();
}
struct EvTa { v4u ta[8]; };
__device__ __forceinline__ void even_item_load_ta(Frame& F, int tid, int rowbase, EvTa& L) {
    const bf16* AG = (const bf16*)(F.ws + WS_BIG + BIG_AG); const bool first = (rowbase & (SEQ - 1)) == 0;
#pragma unroll
    for (int i = 0; i < 8; ++i) { const int q = tid + 512 * i, j = q >> 6, ch = q & 63; const bool inr = q < 62 * 64, ok = inr && (!first || j >= 30);
        const v4u v = *(const GAS v4u*)(AG + (size_t)(rowbase + (ok ? j - 30 : 0)) * DA + 8 * ch); L.ta[i] = ok ? v : (v4u){0u, 0u, 0u, 0u}; }
}
__device__ __forceinline__ void even_prep_light(Frame& F, const Args& args, int e) {
    constexpr int RP = 32, NIP = MP / RP, LW0 = 128, LWN = 128;
    const bf16* BX = (const bf16*)(F.ws + WS_BIG + BIG_BX); bf16* AB = (bf16*)(F.ws + WS_BIG + BIG_AB);
    LAS unsigned char* TA = F.lds + RING_OFF; LAS float* CO = (LAS float*)(F.lds + RING_OFF + 62 * 1024);
    const int c = F.tid, cg = F.tid & 63, rb = F.tid >> 6;
    const int lw = F.bid - LW0;
    if (lw < 0) { if (F.bid < NSAMP) { const int sq = (F.bid & 7) * 16 + (F.bid >> 3); even_prep_item<DSEQ, true>(F, args, e, MP + sq * DSEQ, 0, sq); } return; }
    int it = 64 * (F.bid & 7) + (lw >> 3);
    {
        float w[31];
#pragma unroll
        for (int k = 0; k < 31; ++k) w[k] = INP(7)[(size_t)(e * 31 + k) * DA + c];
        const float bias = INP(8)[e * DA + c];
        const f32x4 g0 = *(const f32x4*)(INP(9) + e * DA + 8 * F.lane), g1 = *(const f32x4*)(INP(9) + e * DA + 8 * F.lane + 4);
        const f32x4 b0 = *(const f32x4*)(INP(10) + e * DA + 8 * F.lane), b1 = *(const f32x4*)(INP(10) + e * DA + 8 * F.lane + 4);
        EvTa cur;
#pragma unroll 1
        for (int k4 = 0; k4 < 4; ++k4, it += 16) {
            const int rowbase = it * RP, t0 = rowbase & (SEQ - 1), b = rowbase >> 11; const bool lastit = t0 == SEQ - 32;
            int tv = F.tid; asm volatile("" : "+v"(tv));
            const int c = tv, cg = tv & 63, rb = tv >> 6, ln = tv & 63;
            even_item_load_ta(F, tv, it * RP, cur);
#pragma unroll
            for (int i = 0; i < 8; ++i) { const int q = tv + 512 * i; if (q < 62 * 64) *(LAS v4u*)(TA + (q >> 6) * 1024 + (q & 63) * 16) = cur.ta[i]; }
            __syncthreads();
#pragma unroll
            for (int hh = 0; hh < 2; ++hh) {
                float in[46];
#pragma unroll
                for (int j = 0; j < 46; ++j) in[j] = bf2f(*(const LAS unsigned short*)(TA + (16 * hh + j) * 1024 + c * 2));
#pragma unroll
                for (int t = 0; t < 16; ++t) { float a = bias;
#pragma unroll
                    for (int k = 0; k < 31; ++k) a = fmaf(w[k], in[t + k], a);
                    CO[(16 * hh + t) * DA + c] = a; }
                if (hh == 1 && lastit) { float* o = F.out + OUT_CA_P + ((size_t)(e * NPROMPT + b) * 30) * DA + c;
#pragma unroll
                    for (int j = 0; j < 30; ++j) o[(size_t)j * DA] = in[16 + j]; }
            }
            __syncthreads();
#pragma unroll
            for (int tt = 0; tt < 4; ++tt) { const int t = F.wave + 8 * tt;
                const f32x4 x0 = *(const LAS f32x4*)(CO + t * DA + 8 * ln), x1 = *(const LAS f32x4*)(CO + t * DA + 8 * ln + 4);
                const float mean = wave_sum((x0.x + x0.y) + (x0.z + x0.w) + (x1.x + x1.y) + (x1.z + x1.w), ln) * (1.0f / DA);
                const f32x4 d0 = x0 - mean, d1 = x1 - mean;
                const float var = wave_sum((d0.x * d0.x + d0.y * d0.y) + (d0.z * d0.z + d0.w * d0.w) + (d1.x * d1.x + d1.y * d1.y) + (d1.z * d1.z + d1.w * d1.w), ln) * (1.0f / DA);
                const float rstd = 1.0f / sqrtf(var + EPS);
                f32x4 y0 = d0 * rstd * g0 + b0, y1 = d1 * rstd * g1 + b1;
#pragma unroll
                for (int i = 0; i < 4; ++i) { y0[i] = silu_f(y0[i]); y1[i] = silu_f(y1[i]); }
                *(GAS v4u*)(AB + (size_t)(rowbase + t) * DM + 8 * ln) = (v4u){pk2(y0.x, y0.y), pk2(y0.z, y0.w), pk2(y1.x, y1.y), pk2(y1.z, y1.w)};
            }
            if (lastit) {
                float* o = F.out + OUT_CB_P + ((size_t)(e * NPROMPT + b) * 2) * DA + c;
                o[0] = bf2f(BX[(size_t)(rowbase + 30) * DA + c]); o[DA] = bf2f(BX[(size_t)(rowbase + 31) * DA + c]); }
        }
        __syncthreads();
    }
}

constexpr int VT_PITCH = 272;
template <int NP>
__device__ __forceinline__ void row_stats(const float* st, float& mean, float& rstd) {
    float s1 = 0.f, s2 = 0.f;
#pragma unroll
    for (int p = 0; p < NP; ++p) { s1 += st[2 * p]; s2 += st[2 * p + 1]; }
    mean = s1 * (1.0f / DM); const float var = fmaxf(s2 * (1.0f / DM) - mean * mean, 0.f); rstd = 1.0f / sqrtf(var + EPS);
}
__device__ __forceinline__ int vt_f(int d) { return (d & 15) ^ (d >> 4); }
struct OdPre { v4u va[2], vb[2]; f32x4 ga, gb, ba, bb; f32x4 wsa[4], wsb[4]; v4u uu[4]; float bs; };
__device__ __forceinline__ void odd_item_load(Frame& F, const Args& args, int o, int it, OdPre& P) {
    const bf16* V = (const bf16*)(F.ws + WS_BIG + BIG_V); const bf16* U = (const bf16*)(F.ws + WS_BIG + BIG_U);
    const int ci = it >> 3, h = it & 7, R0 = ci * 128, tl = F.lane & 15, kq = F.lane >> 4, t = 16 * F.wave + tl;
#pragma unroll
    for (int i2 = 0; i2 < 2; ++i2) { const int q = F.tid + 512 * i2, cc = q & 15, rp = q >> 4, col = h * 128 + cc * 8;
        P.va[i2] = *(const GAS v4u*)(V + (size_t)(R0 + 2 * rp) * DM + col); P.vb[i2] = *(const GAS v4u*)(V + (size_t)(R0 + 2 * rp + 1) * DM + col); }
    { const int col = h * 128 + (F.tid & 15) * 8;
        P.ga = *(const f32x4*)(INP(15) + o * DM + col); P.gb = *(const f32x4*)(INP(15) + o * DM + col + 4); P.ba = *(const f32x4*)(INP(16) + o * DM + col); P.bb = *(const f32x4*)(INP(16) + o * DM + col + 4); }
    { const float* wrow = INP(17) + ((size_t)(o * 8 + h) * 128 + t) * 128 + 8 * kq;
#pragma unroll
        for (int kk = 0; kk < 4; ++kk) {
            if (32 * kk <= 16 * F.wave + 15) { P.wsa[kk] = *(const f32x4*)(wrow + 32 * kk); P.wsb[kk] = *(const f32x4*)(wrow + 32 * kk + 4); }
            else { P.wsa[kk] = (f32x4){0.f, 0.f, 0.f, 0.f}; P.wsb[kk] = P.wsa[kk]; } } }
#pragma unroll
    for (int p = 0; p < 4; ++p) P.uu[p] = *(const GAS v4u*)(U + (size_t)(R0 + t) * DM + h * 128 + 32 * p + 8 * kq);
    P.bs = INP(18)[(o * 8 + h) * 128 + t];
}
__device__ __forceinline__ void odd_prep_sample_item(Frame& F, const Args& args, int o, int s) {
    const bf16* U = (const bf16*)(F.ws + WS_BIG + BIG_U); const bf16* V = (const bf16*)(F.ws + WS_BIG + BIG_V); bf16* US = (bf16*)(F.ws + WS_BIG + BIG_US);
    const float* stat = (const float*)(F.ws + WS_STAT);
    LAS float* RS = (LAS float*)(F.lds + RING_OFF);
    const int R0 = MP + s * DSEQ;
    const int col = 2 * F.tid, h = col >> 7;
    const f32x2 g = *(const f32x2*)(INP(15) + o * DM + col), bb = *(const f32x2*)(INP(16) + o * DM + col);
    unsigned vw[DSEQ], uw[DSEQ];
#pragma unroll
    for (int t = 0; t < DSEQ; ++t) { vw[t] = *(const GAS unsigned*)(V + (size_t)(R0 + t) * DM + col); uw[t] = *(const GAS unsigned*)(U + (size_t)(R0 + t) * DM + col); }
    f32x4 wsv[DSEQ][2]; float bsv[DSEQ];
    { const float* ws = INP(17) + (size_t)(o * 8 + h) * 128 * 128; const float* bsp = INP(18) + (o * 8 + h) * 128;
#pragma unroll
        for (int t = 0; t < DSEQ; ++t) { wsv[t][0] = *(const f32x4*)(ws + t * 128); wsv[t][1] = *(const f32x4*)(ws + t * 128 + 4); bsv[t] = bsp[t]; } }
    if (F.tid < DSEQ) { float mean, rstd; row_stats<32>(stat + (size_t)MP * 32 + (size_t)(s * DSEQ + F.tid) * 64, mean, rstd); RS[2 * F.tid] = mean; RS[2 * F.tid + 1] = rstd; }
    __syncthreads();
    float vn[DSEQ][2];
#pragma unroll
    for (int t = 0; t < DSEQ; ++t) { const unsigned w = vw[t]; const float m = RS[2 * t], r = RS[2 * t + 1];
        vn[t][0] = (bflo(w) - m) * r * g.x + bb.x; vn[t][1] = (bfhi(w) - m) * r * g.y + bb.y;
        *(f32x2*)(F.out + OUT_CV_S + ((size_t)(o * NSAMP + s) * DSEQ + t) * DM + col) = (f32x2){vn[t][0], vn[t][1]}; }
#pragma unroll
    for (int t = 0; t < DSEQ; ++t) { float a0 = bsv[t], a1 = a0; const float wrow[8] = {wsv[t][0].x, wsv[t][0].y, wsv[t][0].z, wsv[t][0].w, wsv[t][1].x, wsv[t][1].y, wsv[t][1].z, wsv[t][1].w};
#pragma unroll
        for (int k = 0; k <= t; ++k) { const float w = wrow[k]; a0 = fmaf(w, vn[k][0], a0); a1 = fmaf(w, vn[k][1], a1); }
        const unsigned uu = uw[t];
        *(GAS unsigned*)(US + (size_t)(R0 + t) * DM + col) = pk2(bflo(uu) * a0, bfhi(uu) * a1); }
    __syncthreads();
}
__device__ __forceinline__ void odd_prep_phase(Frame& F, const Args& args, int o) {
    constexpr int NIP = (MP / 128) * 8, NJ = NIP / 256;
    const bf16* U = (const bf16*)(F.ws + WS_BIG + BIG_U); bf16* US = (bf16*)(F.ws + WS_BIG + BIG_US);
    LAS float* RSall = (LAS float*)(F.lds + RING_OFF + 65536);
    const int tl = F.lane & 15, kq = F.lane >> 4, t = 16 * F.wave + tl, c0 = F.bid;
    const int hh = (c0 >> 3) & 7, cbase = 16 * (c0 & 7) + (c0 >> 6);
    OdPre cur;
    {
        const int j = F.tid >> 7, r = F.tid & 127, row = (cbase + 4 * j) * 128 + r;
        const float* st = (const float*)(F.ws + WS_STAT) + (size_t)row * 32; float s1 = 0.f, s2 = 0.f;
#pragma unroll
        for (int i = 0; i < 8; ++i) { const f32x4 v = *(const f32x4*)(st + 4 * i); s1 += v.x + v.z; s2 += v.y + v.w; }
        const float mean = s1 * (1.0f / DM), var = fmaxf(s2 * (1.0f / DM) - mean * mean, 0.f); RSall[2 * F.tid] = mean; RSall[2 * F.tid + 1] = 1.0f / sqrtf(var + EPS);
    }
    __syncthreads();
#pragma unroll 1
    for (int j = 0; j < NJ; ++j) {
        const int ci = cbase + 4 * j, h = hh, it = ci * 8 + h, R0 = ci * 128, b = ci >> 4; const bool last = (ci & 15) == 15;
        odd_item_load(F, args, o, it, cur);
        LAS unsigned char* VT = F.lds + RING_OFF + (j & 1) * 32768;
        const LAS float* RS = RSall + j * 256;
#pragma unroll
        for (int i2 = 0; i2 < 2; ++i2) {
            const int q = F.tid + 512 * i2, cc = q & 15, rp = q >> 4, s0 = 2 * rp, col = h * 128 + cc * 8;
            const float m0 = RS[2 * s0], r0 = RS[2 * s0 + 1], m1 = RS[2 * s0 + 2], r1 = RS[2 * s0 + 3];
            float n0[8], n1[8];
            const float gv[8] = {cur.ga.x, cur.ga.y, cur.ga.z, cur.ga.w, cur.gb.x, cur.gb.y, cur.gb.z, cur.gb.w}, bv[8] = {cur.ba.x, cur.ba.y, cur.ba.z, cur.ba.w, cur.bb.x, cur.bb.y, cur.bb.z, cur.bb.w};
            const unsigned wav[4] = {cur.va[i2].x, cur.va[i2].y, cur.va[i2].z, cur.va[i2].w}, wbv[4] = {cur.vb[i2].x, cur.vb[i2].y, cur.vb[i2].z, cur.vb[i2].w};
#pragma unroll
            for (int i = 0; i < 4; ++i) {
                n0[2 * i] = (bflo(wav[i]) - m0) * r0 * gv[2 * i] + bv[2 * i]; n0[2 * i + 1] = (bfhi(wav[i]) - m0) * r0 * gv[2 * i + 1] + bv[2 * i + 1];
                n1[2 * i] = (bflo(wbv[i]) - m1) * r1 * gv[2 * i] + bv[2 * i]; n1[2 * i + 1] = (bfhi(wbv[i]) - m1) * r1 * gv[2 * i + 1] + bv[2 * i + 1];
            }
            if (last) { float* cv = F.out + OUT_CV_P + ((size_t)(o * NPROMPT + b) * 128 + s0) * DM + col;
                *(f32x4*)cv = (f32x4){n0[0], n0[1], n0[2], n0[3]}; *(f32x4*)(cv + 4) = (f32x4){n0[4], n0[5], n0[6], n0[7]};
                *(f32x4*)(cv + DM) = (f32x4){n1[0], n1[1], n1[2], n1[3]}; *(f32x4*)(cv + DM + 4) = (f32x4){n1[4], n1[5], n1[6], n1[7]}; }
#pragma unroll
            for (int i = 0; i < 8; ++i) { const int d = cc * 8 + i; *(LAS unsigned*)(VT + d * 256 + (((rp >> 2) ^ vt_f(d)) << 4) + ((rp & 3) << 2)) = pk2(n0[i], n1[i]); }
        }
        __syncthreads();
        const float bs = cur.bs;
        f32x4 acc[8];
#pragma unroll
        for (int n = 0; n < 8; ++n) acc[n] = (f32x4){0.f, 0.f, 0.f, 0.f};
#pragma unroll
        for (int kk = 0; kk < 4; ++kk) {
            if (32 * kk <= 16 * F.wave + 15) {
                const int s0 = 32 * kk + 8 * kq;
                float wv[8] = {cur.wsa[kk].x, cur.wsa[kk].y, cur.wsa[kk].z, cur.wsa[kk].w, cur.wsb[kk].x, cur.wsb[kk].y, cur.wsb[kk].z, cur.wsb[kk].w};
#pragma unroll
                for (int jj = 0; jj < 8; ++jj) wv[jj] = (s0 + jj <= t) ? wv[jj] : 0.f;
                v4u wp; wp.x = pk2(wv[0], wv[1]); wp.y = pk2(wv[2], wv[3]); wp.z = pk2(wv[4], wv[5]); wp.w = pk2(wv[6], wv[7]);
                const bf16x8 wf = __builtin_bit_cast(bf16x8, wp);
#pragma unroll
                for (int n = 0; n < 8; ++n) { const int d = 32 * (n >> 1) + 8 * (tl >> 2) + 4 * (n & 1) + (tl & 3);
                    const bf16x8 vf = *(const LAS bf16x8*)(VT + d * 256 + (((4 * kk + kq) ^ vt_f(d)) << 4));
                    acc[n] = __builtin_amdgcn_mfma_f32_16x16x32_bf16(vf, wf, acc[n], 0, 0, 0); }
            }
        }
#pragma unroll
        for (int p = 0; p < 4; ++p) { const size_t off = (size_t)(R0 + t) * DM + h * 128 + 32 * p + 8 * kq; const f32x4 a0 = acc[2 * p], a1 = acc[2 * p + 1]; const v4u w = cur.uu[p];
            *(GAS v4u*)(US + off) = (v4u){pk2(bflo(w.x) * (a0.x + bs), bfhi(w.x) * (a0.y + bs)), pk2(bflo(w.y) * (a0.z + bs), bfhi(w.y) * (a0.w + bs)),
                                          pk2(bflo(w.z) * (a1.x + bs), bfhi(w.z) * (a1.y + bs)), pk2(bflo(w.w) * (a1.z + bs), bfhi(w.w) * (a1.w + bs))}; }
    }
    __syncthreads();
    if (c0 < NSAMP) odd_prep_sample_item(F, args, o, (c0 & 7) * 16 + (c0 >> 3));
}

__global__ void __launch_bounds__(NWAVES * 64, 2) skel_fwd(Args args) {
    extern __shared__ __attribute__((aligned(16))) unsigned char lds[];
    Frame F;
    F.lds = (LAS unsigned char*)lds;
    F.MISC = (volatile LAS unsigned*)(F.lds + MISC_OFF);
    F.tid = threadIdx.x; F.lane = F.tid & 63; F.wave = __builtin_amdgcn_readfirstlane(F.tid >> 6);
    F.G = gridDim.x;
    F.z = 0; F.out = args.out; F.ws = args.ws;
    F.ctl = (gu32*)(args.ws + WS_CTL);
    for (int u = F.tid; u < (LDS_BYTES - LDSCTL_OFF) / 4; u += NWAVES * 64) ((LAS unsigned*)(F.lds + LDSCTL_OFF))[u] = 0u;
    __syncthreads();
    XcdBarrier bar; bar.bar = (unsigned*)(F.ctl + CW_BAR); bar.x = 0; bar.st = nullptr;
#if MK_ONE_LAUNCH
    bar = xcd_barrier_post((unsigned*)(F.ctl + CW_BAR), F.MISC + 8);
#endif
    const int lo = args.ph_lo, hi = args.ph_hi;
    bool repeated = false;
#pragma unroll 1
    for (int p = lo; p < hi; ++p) {
        { int z = 0; asm volatile("" : "+s"(z)); F.z = z; F.out = args.out + z; F.ws = args.ws + z;
          int t_ = threadIdx.x; asm volatile("" : "+v"(t_)); F.tid = t_; F.lane = t_ & 63; F.wave = __builtin_amdgcn_readfirstlane(t_ >> 6);
          int b_ = blockIdx.x; asm volatile("" : "+s"(b_)); F.bid = b_; }
        float* const X = F.out + OUT_Y;
        int kind = -1;
        pg8::Gemm g{nullptr, nullptr, nullptr, 0, 0, 0}; pg8::EpiAny E{0, false, 0, nullptr, nullptr, nullptr, nullptr, nullptr, nullptr, nullptr, nullptr, nullptr};
        bf16* const H = (bf16*)(F.ws + WS_H);
        if (p == 0) { p0_prologue(F, args); }
        else if (p == 1) {
            kind = 0; g = pg8::Gemm{(const bf16*)(F.ws + WS_CACT), (const bf16*)(F.ws + WS_WADA), (const bf16*)(F.ws + WS_CACT), 256, NMOD, DM};
            E.kind = 0; E.perm = false; E.ldc = NMOD; E.p0 = (void*)(F.ws + WS_MOD); E.f0 = INP(21);
        } else if (p == 2) {
            norm_phase(F, args, INP(0), INP(1), INP(22), (const float*)(F.ws + WS_MOD) + 0 * DM, (const float*)(F.ws + WS_MOD) + 1 * DM, H);
        } else {
            const int l = (p - 3) / 5, k = (p - 3) % 5, eo = l >> 1; const bool even = (l & 1) == 0;
            bf16* const XB = (bf16*)(F.ws + WS_XB);
            const float* xp = l == 0 ? INP(0) : (const float*)XB; const float* xs = l == 0 ? INP(1) : (const float*)(XB + (size_t)MP * DM);
            const float* modl = (const float*)(F.ws + WS_MOD) + (size_t)l * NMODL;
            if (k == 1) {
                if (even) {
                    kind = 5; g = pg8::Gemm{H, (const bf16*)(F.ws + WS_WINAB) + (size_t)eo * DIN_E * DM + (size_t)2048 * DM, H + (size_t)MP * DM, MP, 512, DM};
                    E.kind = 5; E.perm = true; E.p0 = (void*)(F.ws + WS_BIG + BIG_AB); E.p1 = (void*)(F.ws + WS_BIG + BIG_BX); E.f0 = INP(11) + (size_t)eo * 3 * DA; E.f1 = INP(3) + (size_t)eo * NSAMP * 2 * DA;
                } else odd_prep_phase(F, args, eo);
            }
            else if (k == 0) {
                if (even) { kind = 1; g = pg8::Gemm{H, (const bf16*)(F.ws + WS_WINAB) + (size_t)eo * DIN_E * DM, H + (size_t)MP * DM, MP, 2048, DM};
                    E.kind = 1; E.perm = true; E.p0 = (void*)(F.ws + WS_BIG + BIG_AG); E.p1 = (void*)(F.ws + WS_BIG + BIG_BX); E.p2 = (void*)(F.ws + WS_BIG + BIG_BB); }
                else { kind = 2; g = pg8::Gemm{H, (const bf16*)(F.ws + WS_WINC) + (size_t)eo * 2048 * DM, H + (size_t)MP * DM, MP, 2048, DM};
                    E.kind = 2; E.perm = true; E.p0 = (void*)(F.ws + WS_BIG + BIG_U); E.p1 = (void*)(F.ws + WS_BIG + BIG_V); E.f0 = INP(14) + (size_t)eo * 2048; E.f3 = (float*)(F.ws + WS_STAT); }
            } else if (k == 3) {
                kind = 4; g = pg8::Gemm{H, (const bf16*)(F.ws + WS_WFF1) + (size_t)l * DFF * DM, H + (size_t)MP * DM, MP, DFF, DM};
                E.kind = 4; E.perm = true; E.ldc = DFF; E.p0 = (void*)(F.ws + WS_BIG);
            } else {
                kind = 3; const int seam = 2 * l + (k == 4);
                if (k == 2) { const bf16* Amix = even ? (const bf16*)(F.ws + WS_BIG + BIG_AB) : (const bf16*)(F.ws + WS_BIG + BIG_US);
                    g = pg8::Gemm{Amix, (even ? (const bf16*)(F.ws + WS_WOUTAB) : (const bf16*)(F.ws + WS_WOUTC)) + (size_t)eo * DM * DM, Amix + (size_t)MP * DM, MP, DM, DM};
                    E.f0 = INP(22) + (size_t)seam * DM; E.f1 = modl; E.ldc = 0;
                    E.f2 = modl + 2 * DM; E.f4 = INP(22) + (size_t)(l * 2 + 1) * DM; E.f5 = modl + 3 * DM; }
                else { g = pg8::Gemm{(const bf16*)(F.ws + WS_BIG), (const bf16*)(F.ws + WS_WFF2) + (size_t)l * DM * DFF, (const bf16*)(F.ws + WS_BIG) + (size_t)MP * DFF, MP, DM, DFF};
                    E.f0 = INP(22) + (size_t)seam * DM; E.f1 = modl + 3 * DM; E.f2 = modl + 5 * DM;
                    if (l == 3) { E.ldc = 1; E.f4 = INP(25); E.f5 = modl; } else { E.f4 = INP(22) + (size_t)((l + 1) * 2 + 0) * DM; E.f5 = modl + NMODL; } }
                E.kind = 3; E.perm = true; E.f3 = X; E.p0 = (void*)H; E.ldc |= seam << 8;
                E.p1 = (void*)(F.ws + WS_XBUF); E.p2 = (void*)((unsigned*)(F.ws + WS_CTL) + CW_SEAM + seam * 64 * 64);
            }
        }
        if (kind >= 0) {
            pg8::StaticOrder S; S.init(g.M, g.N, F.G, F.bid);
            pg8::gemm_phase<pg8::EpiAny, pg8::StaticOrder, PG8_ALIGN, PG8_SP2>(F.lds + RING_OFF, g, S, E);
            if (kind == 0 && F.bid >= 96) {
                int t_ = threadIdx.x; asm volatile("" : "+v"(t_)); F.tid = t_; F.lane = t_ & 63; F.wave = __builtin_amdgcn_readfirstlane(t_ >> 6);
                p0_items<true>(F, args, (F.bid - 96) * NWAVES + F.wave, (F.G - 96) * NWAVES); }
            if (kind == 5) {
                int t_ = threadIdx.x; asm volatile("" : "+v"(t_)); F.tid = t_; F.lane = t_ & 63; F.wave = __builtin_amdgcn_readfirstlane(t_ >> 6);
                even_prep_light(F, args, ((p - 3) / 5) >> 1); }
        }
        if (p + 1 < hi) xcd_barrier(bar);
        if (REP_P >= 0 && p == REP_P && !repeated) { repeated = true; --p; }
    }
}

extern "C" void kernel_launch(void* const* d_in, const int* in_sizes, int n_in, void* d_out, int out_size, void* d_ws, size_t ws_size, hipStream_t stream) {
    static int grid = 0;
    if (grid == 0) {
        if (n_in != 26 || out_size != (int)OUT_END || ws_size < WS_END) { fprintf(stderr, "kernel_launch: unexpected shapes: n_in %d out %d ws %zu\n", n_in, out_size, ws_size); grid = -1; return; }
        int dev = 0, cus = 0, per_cu = 0;
        if (hipGetDevice(&dev) != hipSuccess || hipDeviceGetAttribute(&cus, hipDeviceAttributeMultiprocessorCount, dev) != hipSuccess) { grid = -1; return; }
        if (hipFuncSetAttribute((const void*)skel_fwd, hipFuncAttributeMaxDynamicSharedMemorySize, LDS_BYTES) != hipSuccess) { fprintf(stderr, "kernel_launch: hipFuncSetAttribute failed\n"); grid = -1; return; }
        if (hipOccupancyMaxActiveBlocksPerMultiprocessor(&per_cu, (const void*)skel_fwd, NWAVES * 64, LDS_BYTES) != hipSuccess || per_cu < 1) { fprintf(stderr, "kernel_launch: occupancy query says %d workgroups per CU\n", per_cu); (void)hipGetLastError(); grid = -1; return; }
        if (cus != 256) { fprintf(stderr, "kernel_launch: built for a 256-CU device (the fused norm epilogues need one 272x256 unit per workgroup); this device has %d CUs\n", cus); grid = -1; return; }
        grid = cus;
    }
    if (grid < 0) return;
    (void)hipMemsetAsync((char*)d_ws + WS_CTL, 0, CTL_ZERO_BYTES, stream);
    Args a{};
    for (int i = 0; i < 26; ++i) a.in[i] = (const float*)d_in[i];
    a.out = (float*)d_out; a.ws = (unsigned char*)d_ws;
#if MK_ONE_LAUNCH
    a.ph_lo = 0; a.ph_hi = N_PHASES; a.li = 0;
    hipLaunchKernelGGL(skel_fwd, dim3(grid), dim3(NWAVES * 64), LDS_BYTES, stream, a);
#else
    for (int p = 0; p < N_PHASES; ++p) { a.ph_lo = p; a.ph_hi = p + 1; a.li = p; hipLaunchKernelGGL(skel_fwd, dim3(grid), dim3(NWAVES * 64), LDS_BYTES, stream, a); }
#endif
}
```

```cpp
#include <hip/hip_runtime.h>
#include <cstdio>
#include <cstdint>

#ifndef PH_MASK
#define PH_MASK 0xFFFF
#endif
#define PH_ON(b) ((PH_MASK >> (b)) & 1)
#ifndef REP_P
#define REP_P -1
#endif
#ifndef MK_ONE_LAUNCH
#define MK_ONE_LAUNCH 1
#endif

constexpr int DM = 1024, NPROMPT = 8, SEQ = 2048, NSAMP = 128, DSEQ = 8;
constexpr int MP = NPROMPT * SEQ;
constexpr int MS = NSAMP * DSEQ;
constexpr int MT = MP + MS;
constexpr int NSEQ = NPROMPT + NSAMP;
constexpr int DA = 512, DIN_E = 2560, DFF = 4096, NMODL = 6 * DM, NMOD = 4 * NMODL;
constexpr float EPS = 1e-6f;

__device__ __forceinline__ float shfl_xor_l(float v, int mask, int lane) { return __builtin_bit_cast(float, __builtin_amdgcn_ds_bpermute((lane ^ mask) << 2, __builtin_bit_cast(int, v))); }
__device__ __forceinline__ int seq_of_row(int row) { return row < MP ? (row >> 11) : NPROMPT + ((row - MP) >> 3); }

namespace pg8 {
#define PG8_LAS __attribute__((address_space(3)))
typedef unsigned short bf16_t;
typedef short bf16x8 __attribute__((ext_vector_type(8)));
typedef float f32x4 __attribute__((ext_vector_type(4)));
typedef unsigned u32x4 __attribute__((ext_vector_type(4)));
constexpr int BM = 256, BK = 64, HALF = 128, HTB = HALF * BK * 2  , STAGE_BYTES = 8 * HTB, NXCD = 8, WGM = 8;

__host__ __device__ __forceinline__ int lds_byte(int r, int c) { const int st = (r >> 4) * 2 + (c >> 5), rr = r & 15, cc = c & 31, ob = rr * 64 + cc * 2; return st * 1024 + (ob ^ (((ob >> 9) & 1) << 5)); }
__host__ __device__ __forceinline__ void stage_rc(int b, int& R, int& C) { const int st = b / 1024, sb = b % 1024, swz = sb ^ (((sb >> 9) & 1) << 5); R = (st >> 1) * 16 + swz / 64; C = (st & 1) * 32 + (swz % 64) / 2; }
__host__ __device__ __forceinline__ int perm32(int rho) { const int n = rho >> 4, i = rho & 15; return 8 * (i >> 2) + 4 * n + (i & 3); }

struct Unit { int pm, pn; };
struct Gemm { const bf16_t* A; const bf16_t* Bt; const bf16_t* AX; int M, N, K; };

struct StaticOrder {
    int nM, nN, nwg, G, c;
    __host__ __device__ void init(int M, int N, int G_, int c_) { nM = M / BM; nN = N / BM; nwg = nM * nN; G = G_; c = c_; }
    __host__ __device__ bool next(int i, Unit& u) const {
        const long L = (long)i * G + c; if (L >= nwg) return false;
        int wgid = (int)L; { const int q = nwg / NXCD, r = nwg % NXCD, xcd = wgid % NXCD, off = wgid / NXCD; wgid = (xcd < r ? xcd * (q + 1) : r * (q + 1) + (xcd - r) * q) + off; }
        const int nig = WGM * nN, gid = wgid / nig, fm = gid * WGM, gsz = (nM - fm) < WGM ? (nM - fm) : WGM;
        u.pm = fm + ((wgid % nig) % gsz); u.pn = (wgid % nig) / gsz; return true;
    }
    __device__ __forceinline__ void a_ready(const Unit&) const {}
    __device__ __forceinline__ void done(const Unit&) const {}
};

typedef float cvt_f32x2_ __attribute__((ext_vector_type(2)));
typedef __bf16 cvt_bf16x2_ __attribute__((ext_vector_type(2)));
__device__ __forceinline__ unsigned cvt_pk_bf16(float lo, float hi) { const cvt_f32x2_ v = {lo, hi}; return __builtin_bit_cast(unsigned, __builtin_convertvector(v, cvt_bf16x2_)); }
__device__ __forceinline__ float sigmoid_f(float x) { return __builtin_amdgcn_rcpf(1.0f + __expf(-x)); }
__device__ __forceinline__ float gelu_tanh_f(float x) { const float y = 1.5957691216057308f * (x + 0.044715f * x * x * x); return x * sigmoid_f(y); }

struct EpiF32 {
    static constexpr bool PERM = false, AFTER_DRAIN = false;
    float* C; int ldc; const float* bias;
    __device__ __forceinline__ void operator()(const f32x4 (&acc)[2][2][4][2], const f32x4 (&accx)[2], const Unit& u, int wr, int wc, int fr, int fq) const {
        const int row0 = u.pm * BM + wr * 64 + fr, col0 = u.pn * BM + wc * 32 + 4 * fq;
        f32x4 bv[2][2];
#pragma unroll
        for (int bj = 0; bj < 2; ++bj)
#pragma unroll
            for (int n = 0; n < 2; ++n) bv[bj][n] = *(const f32x4*)(bias + col0 + bj * HALF + n * 16);
#pragma unroll
        for (int ai = 0; ai < 2; ++ai)
#pragma unroll
            for (int m = 0; m < 4; ++m) { float* rowp = C + (size_t)(row0 + ai * HALF + m * 16) * ldc + col0;
#pragma unroll
                for (int bj = 0; bj < 2; ++bj)
#pragma unroll
                    for (int n = 0; n < 2; ++n) *(f32x4*)(rowp + bj * HALF + n * 16) = acc[ai][bj][m][n] + bv[bj][n]; }
    }
};
struct EpiResid {
    static constexpr bool PERM = false, AFTER_DRAIN = false;
    const float* xp; const float* xs; float* out; const float* gate;
    __device__ __forceinline__ void operator()(const f32x4 (&acc)[2][2][4][2], const f32x4 (&accx)[2], const Unit& u, int wr, int wc, int fr, int fq) const {
        const int row0 = u.pm * BM + wr * 64 + fr, col0 = u.pn * BM + wc * 32 + 4 * fq;
        {
            const int srow = 16 * u.pm + fr, colx = u.pn * BM + wc * 32 + 16 * wr + 4 * fq;
            const float* src = xs + (size_t)srow * DM + colx; const float* g = gate + (size_t)(NPROMPT + (srow >> 3)) * NMOD + colx; float* dst = out + (size_t)(MP + srow) * DM + colx;
#pragma unroll
            for (int bj = 0; bj < 2; ++bj) { const f32x4 b = *(const f32x4*)(src + bj * HALF), gv = *(const f32x4*)(g + bj * HALF); *(f32x4*)(dst + bj * HALF) = b + gv * accx[bj]; }
        }
#pragma unroll
        for (int ai = 0; ai < 2; ++ai)
#pragma unroll
            for (int m = 0; m < 4; ++m) {
                const int row = row0 + ai * HALF + m * 16;
                const float* src = (row < MP ? xp + (size_t)row * DM : xs + (size_t)(row - MP) * DM) + col0;
                const float* g = gate + (size_t)seq_of_row(row) * NMOD + col0;
                float* dst = out + (size_t)row * DM + col0;
#pragma unroll
                for (int bj = 0; bj < 2; ++bj)
#pragma unroll
                    for (int n = 0; n < 2; ++n) { const f32x4 b = *(const f32x4*)(src + bj * HALF + n * 16), gv = *(const f32x4*)(g + bj * HALF + n * 16);
                        *(f32x4*)(dst + bj * HALF + n * 16) = b + gv * acc[ai][bj][m][n]; }
            }
    }
};
struct EpiRelu2 {
    static constexpr bool PERM = true, AFTER_DRAIN = false;
    bf16_t* O; int ldc;
    __device__ __forceinline__ void operator()(const f32x4 (&acc)[2][2][4][2], const f32x4 (&accx)[2], const Unit& u, int wr, int wc, int fr, int fq) const {
        const int row0 = u.pm * BM + wr * 64 + fr, col0 = u.pn * BM + wc * 32 + 8 * fq;
        {
            bf16_t* rowp = O + (size_t)(MP + 16 * u.pm + fr) * ldc + col0 + 4 * wr;
#pragma unroll
            for (int bj = 0; bj < 2; ++bj) { f32x4 v = __builtin_elementwise_max(accx[bj], (f32x4){0.f, 0.f, 0.f, 0.f}); v = v * v;
                typedef unsigned u32x2v __attribute__((ext_vector_type(2))); *(u32x2v*)(rowp + bj * HALF) = (u32x2v){cvt_pk_bf16(v[0], v[1]), cvt_pk_bf16(v[2], v[3])}; }
        }
#pragma unroll
        for (int ai = 0; ai < 2; ++ai)
#pragma unroll
            for (int m = 0; m < 4; ++m) { bf16_t* rowp = O + (size_t)(row0 + ai * HALF + m * 16) * ldc + col0;
#pragma unroll
                for (int bj = 0; bj < 2; ++bj) { f32x4 v0 = acc[ai][bj][m][0], v1 = acc[ai][bj][m][1];
                    v0 = __builtin_elementwise_max(v0, (f32x4){0.f, 0.f, 0.f, 0.f}); v1 = __builtin_elementwise_max(v1, (f32x4){0.f, 0.f, 0.f, 0.f}); v0 = v0 * v0; v1 = v1 * v1;
                    u32x4 w; w.x = cvt_pk_bf16(v0[0], v0[1]); w.y = cvt_pk_bf16(v0[2], v0[3]); w.z = cvt_pk_bf16(v1[0], v1[1]); w.w = cvt_pk_bf16(v1[2], v1[3]);
                    *(u32x4*)(rowp + bj * HALF) = w; } }
    }
};
struct EpiEvenIn {
    static constexpr bool PERM = true, AFTER_DRAIN = false;
    bf16_t *AG, *BX, *BB;
    __device__ __forceinline__ void operator()(const f32x4 (&acc)[2][2][4][2], const f32x4 (&accx)[2], const Unit& u, int wr, int wc, int fr, int fq) const {
        const int row0 = u.pm * BM + wr * 64 + fr, cw = wc * 32 + 8 * fq;
        {
            typedef unsigned u32x2v __attribute__((ext_vector_type(2)));
            const size_t xrow = (size_t)(MP + 16 * u.pm + fr) * DA; const int cx = cw + 4 * wr;
            if (u.pn < 8) { f32x4 r;
                if (u.pn < 4) {
#pragma unroll
                    for (int i = 0; i < 4; ++i) r[i] = accx[0][i] * sigmoid_f(accx[1][i]);
                } else r = accx[0] * accx[1];
                *(u32x2v*)((u.pn < 4 ? AG : BX) + xrow + 128 * (u.pn & 3) + cx) = (u32x2v){cvt_pk_bf16(r[0], r[1]), cvt_pk_bf16(r[2], r[3])};
            } else {
#pragma unroll
                for (int bj = 0; bj < 2; ++bj) *(u32x2v*)(BB + xrow + 256 * (u.pn - 8) + bj * HALF + cx) = (u32x2v){cvt_pk_bf16(accx[bj][0], accx[bj][1]), cvt_pk_bf16(accx[bj][2], accx[bj][3])};
            }
        }
        if (u.pn < 8) {
            bf16_t* O = (u.pn < 4 ? AG : BX) + 128 * (u.pn & 3) + cw; const bool glu = u.pn < 4;
#pragma unroll
            for (int ai = 0; ai < 2; ++ai)
#pragma unroll
                for (int m = 0; m < 4; ++m) { bf16_t* rowp = O + (size_t)(row0 + ai * HALF + m * 16) * DA;
                    const f32x4 a0 = acc[ai][0][m][0], a1 = acc[ai][0][m][1], g0 = acc[ai][1][m][0], g1 = acc[ai][1][m][1]; f32x4 r0, r1;
                    if (glu) {
#pragma unroll
                        for (int i = 0; i < 4; ++i) { r0[i] = a0[i] * sigmoid_f(g0[i]); r1[i] = a1[i] * sigmoid_f(g1[i]); }
                    } else { r0 = a0 * g0; r1 = a1 * g1; }
                    u32x4 w; w.x = cvt_pk_bf16(r0[0], r0[1]); w.y = cvt_pk_bf16(r0[2], r0[3]); w.z = cvt_pk_bf16(r1[0], r1[1]); w.w = cvt_pk_bf16(r1[2], r1[3]);
                    *(u32x4*)rowp = w; }
        } else {
            bf16_t* O = BB + 256 * (u.pn - 8) + cw;
#pragma unroll
            for (int ai = 0; ai < 2; ++ai)
#pragma unroll
                for (int m = 0; m < 4; ++m) { bf16_t* rowp = O + (size_t)(row0 + ai * HALF + m * 16) * DA;
#pragma unroll
                    for (int bj = 0; bj < 2; ++bj) { const f32x4 v0 = acc[ai][bj][m][0], v1 = acc[ai][bj][m][1];
                        u32x4 w; w.x = cvt_pk_bf16(v0[0], v0[1]); w.y = cvt_pk_bf16(v0[2], v0[3]); w.z = cvt_pk_bf16(v1[0], v1[1]); w.w = cvt_pk_bf16(v1[2], v1[3]);
                        *(u32x4*)(rowp + bj * HALF) = w; } }
        }
    }
};
struct EpiOddIn {
    static constexpr bool PERM = true, AFTER_DRAIN = false;
    bf16_t *U, *V; const float* bias; float* stat;
    __device__ __forceinline__ void operator()(const f32x4 (&acc)[2][2][4][2], const f32x4 (&accx)[2], const Unit& u, int wr, int wc, int fr, int fq) const {
        const int row0 = u.pm * BM + wr * 64 + fr, cw = wc * 32 + 8 * fq, bcol0 = u.pn * BM + cw;
        const bool isv = u.pn >= 4;
        bf16_t* O = (isv ? V + 256 * (u.pn - 4) : U + 256 * u.pn) + cw;
        {
            typedef unsigned u32x2v __attribute__((ext_vector_type(2))); typedef float f32x2v __attribute__((ext_vector_type(2)));
            const int srow = 16 * u.pm + fr; bf16_t* rowp = O + (size_t)(MP + srow) * DM + 4 * wr; float s1 = 0.f, s2 = 0.f;
#pragma unroll
            for (int bj = 0; bj < 2; ++bj) { f32x4 v = accx[bj] + *(const f32x4*)(bias + bcol0 + bj * HALF + 4 * wr);
#pragma unroll
                for (int i = 0; i < 4; ++i) v[i] = gelu_tanh_f(v[i]);
                s1 += (v[0] + v[1]) + (v[2] + v[3]); s2 += (v[0] * v[0] + v[1] * v[1]) + (v[2] * v[2] + v[3] * v[3]);
                *(u32x2v*)(rowp + bj * HALF) = (u32x2v){cvt_pk_bf16(v[0], v[1]), cvt_pk_bf16(v[2], v[3])}; }
            if (isv) { s1 += __shfl_xor(s1, 16); s1 += __shfl_xor(s1, 32); s2 += __shfl_xor(s2, 16); s2 += __shfl_xor(s2, 32);
                if (fq == 0) *(f32x2v*)(stat + (size_t)MP * 32 + ((size_t)srow * 32 + (u.pn - 4) * 8 + wr * 4 + wc) * 2) = (f32x2v){s1, s2}; }
        }
        f32x4 bv[2][2];
#pragma unroll
        for (int bj = 0; bj < 2; ++bj)
#pragma unroll
            for (int n = 0; n < 2; ++n) bv[bj][n] = *(const f32x4*)(bias + bcol0 + bj * HALF + 4 * n);
#pragma unroll
        for (int ai = 0; ai < 2; ++ai)
#pragma unroll
            for (int m = 0; m < 4; ++m) { const int row = row0 + ai * HALF + m * 16; bf16_t* rowp = O + (size_t)row * DM; float s1 = 0.f, s2 = 0.f;
#pragma unroll
                for (int bj = 0; bj < 2; ++bj) { f32x4 v0 = acc[ai][bj][m][0] + bv[bj][0], v1 = acc[ai][bj][m][1] + bv[bj][1];
#pragma unroll
                    for (int i = 0; i < 4; ++i) { v0[i] = gelu_tanh_f(v0[i]); v1[i] = gelu_tanh_f(v1[i]); }
                    s1 += (v0[0] + v0[1]) + (v0[2] + v0[3]) + (v1[0] + v1[1]) + (v1[2] + v1[3]);
                    s2 += (v0[0] * v0[0] + v0[1] * v0[1]) + (v0[2] * v0[2] + v0[3] * v0[3]) + (v1[0] * v1[0] + v1[1] * v1[1]) + (v1[2] * v1[2] + v1[3] * v1[3]);
                    u32x4 w; w.x = cvt_pk_bf16(v0[0], v0[1]); w.y = cvt_pk_bf16(v0[2], v0[3]); w.z = cvt_pk_bf16(v1[0], v1[1]); w.w = cvt_pk_bf16(v1[2], v1[3]);
                    *(u32x4*)(rowp + bj * HALF) = w; }
                if (isv) { s1 += __shfl_xor(s1, 16); s1 += __shfl_xor(s1, 32); s2 += __shfl_xor(s2, 16); s2 += __shfl_xor(s2, 32);
                    if (fq == 0) { typedef float f32x2v __attribute__((ext_vector_type(2))); *(f32x2v*)(stat + ((size_t)row * 16 + (u.pn - 4) * 4 + wc) * 2) = (f32x2v){s1, s2}; } }
            }
    }
};

struct EpiBBconv {
    static constexpr bool PERM = true;
    const bf16_t* BX; bf16_t* AB; const float* cw; const float* hist;
    __device__ __forceinline__ static f32x4 bf4(unsigned a, unsigned b) { return (f32x4){__builtin_bit_cast(float, a << 16), __builtin_bit_cast(float, a & 0xffff0000u), __builtin_bit_cast(float, b << 16), __builtin_bit_cast(float, b & 0xffff0000u)}; }
    __device__ __forceinline__ void operator()(const f32x4 (&acc)[2][2][4][2], const f32x4 (&accx)[2], const Unit& u, int wr, int wc, int fr_in, int fq) const {
        typedef unsigned u32x2v __attribute__((ext_vector_type(2)));
        const int cwv = u.pn * BM + wc * 32 + 8 * fq;
        {   const int fr = fr_in;
            const int srow = 16 * u.pm + fr, t = srow & 7, sq = srow >> 3;
#pragma unroll
            for (int bj = 0; bj < 2; ++bj) { const int c = cwv + bj * HALF + 4 * wr;
                const f32x4 w0 = *(const f32x4*)(cw + c), w1 = *(const f32x4*)(cw + DA + c), w2 = *(const f32x4*)(cw + 2 * DA + c);
                const u32x2v x2 = *(const u32x2v*)(BX + (size_t)(MP + srow) * DA + c), x1 = *(const u32x2v*)(BX + (size_t)(MP + srow - (t >= 1 ? 1 : 0)) * DA + c), x0 = *(const u32x2v*)(BX + (size_t)(MP + srow - (t >= 2 ? 2 : 0)) * DA + c);
                const f32x4 h1 = *(const f32x4*)(hist + ((size_t)sq * 2 + 1) * DA + c), h0 = *(const f32x4*)(hist + ((size_t)sq * 2 + (t >= 1 ? 1 : 0)) * DA + c);
                const f32x4 b2 = bf4(x2.x, x2.y), b1 = t >= 1 ? bf4(x1.x, x1.y) : h1, b0 = t >= 2 ? bf4(x0.x, x0.y) : h0;
                const f32x4 o = accx[bj] * (w0 * b0 + w1 * b1 + w2 * b2);
                *(u32x2v*)(AB + (size_t)(MP + srow) * DM + DA + c) = (u32x2v){cvt_pk_bf16(o[0], o[1]), cvt_pk_bf16(o[2], o[3])}; }
        }
#pragma unroll
        for (int bj = 0; bj < 2; ++bj) { const int c = cwv + bj * HALF;
            f32x4 w[3][2];
#pragma unroll
            for (int k = 0; k < 3; ++k) { w[k][0] = *(const f32x4*)(cw + k * DA + c); w[k][1] = *(const f32x4*)(cw + k * DA + c + 4); }
#pragma unroll
            for (int am = 0; am < 4; ++am) { const int ai = am >> 1, mb = (am & 1) * 2;
                int fr = fr_in; asm volatile("" : "+v"(fr));
                u32x4 xr[2][3];
#pragma unroll
                for (int mm = 0; mm < 2; ++mm) { const int row = u.pm * BM + ai * HALF + wr * 64 + (mb + mm) * 16 + fr, t = row & (SEQ - 1);
#pragma unroll
                    for (int d = 0; d < 3; ++d) xr[mm][d] = *(const u32x4*)(BX + (size_t)(row - (t >= d ? d : 0)) * DA + c); }
#pragma unroll
                for (int mm = 0; mm < 2; ++mm) { const int m = mb + mm, row = u.pm * BM + ai * HALF + wr * 64 + m * 16 + fr, t = row & (SEQ - 1);
                    const f32x4 z = (f32x4){0.f, 0.f, 0.f, 0.f};
                    const f32x4 b2l = bf4(xr[mm][0].x, xr[mm][0].y), b2h = bf4(xr[mm][0].z, xr[mm][0].w);
                    const f32x4 b1l = t >= 1 ? bf4(xr[mm][1].x, xr[mm][1].y) : z, b1h = t >= 1 ? bf4(xr[mm][1].z, xr[mm][1].w) : z;
                    const f32x4 b0l = t >= 2 ? bf4(xr[mm][2].x, xr[mm][2].y) : z, b0h = t >= 2 ? bf4(xr[mm][2].z, xr[mm][2].w) : z;
                    const f32x4 ol = acc[ai][bj][m][0] * (w[0][0] * b0l + w[1][0] * b1l + w[2][0] * b2l), oh = acc[ai][bj][m][1] * (w[0][1] * b0h + w[1][1] * b1h + w[2][1] * b2h);
                    *(u32x4*)(AB + (size_t)row * DM + DA + c) = (u32x4){cvt_pk_bf16(ol[0], ol[1]), cvt_pk_bf16(ol[2], ol[3]), cvt_pk_bf16(oh[0], oh[1]), cvt_pk_bf16(oh[2], oh[3])}; }
                asm volatile("" ::: "memory"); }
        }
    }
};
struct EpiResidNorm {
    static constexpr bool PERM = true;
    const void* xp; const void* xs; void* out; const float* gate;
    bf16_t* H; const float* ng; const float* msh; float* xbuf; unsigned* cnt; bool fin, xf32; float* rn; unsigned epoch;
    typedef unsigned u32x2v_ __attribute__((ext_vector_type(2)));
    __device__ __forceinline__ static float inv_scale(float d) { return __builtin_amdgcn_rcpf(__builtin_copysignf(__builtin_fmaxf(__builtin_fabsf(d), 0x1p-12f), d)); }
    __device__ __forceinline__ static f32x4 bf4(unsigned a, unsigned b) { return (f32x4){__builtin_bit_cast(float, a << 16), __builtin_bit_cast(float, a & 0xffff0000u), __builtin_bit_cast(float, b << 16), __builtin_bit_cast(float, b & 0xffff0000u)}; }
    __device__ __forceinline__ void ld8(const void* base, size_t off, f32x4& lo, f32x4& hi) const {
        if (xf32) { lo = *(const f32x4*)((const float*)base + off); hi = *(const f32x4*)((const float*)base + off + 4); }
        else { const u32x4 w = *(const u32x4*)((const bf16_t*)base + off); lo = bf4(w.x, w.y); hi = bf4(w.z, w.w); }
    }
    __device__ __forceinline__ f32x4 ld4(const void* base, size_t off) const {
        if (xf32) return *(const f32x4*)((const float*)base + off);
        const u32x2v_ w = *(const u32x2v_*)((const bf16_t*)base + off); return bf4(w.x, w.y);
    }
    __device__ __forceinline__ void fused(f32x4 (&acc)[2][2][4][2], f32x4 (&accx)[2], const Unit& u, int wr, int wc, int fr, int fq, PG8_LAS unsigned char* lds, int wid, int lane) const {
        PG8_LAS float* P = (PG8_LAS float*)lds;
        PG8_LAS float* PX = (PG8_LAS float*)(lds + 4096);
        PG8_LAS float* S = (PG8_LAS float*)(lds + 4096 + 512);
        const int col0 = u.pn * BM + wc * 32 + 8 * fq, colx = col0 + 4 * wr, tid = wid * 64 + lane;
        f32x4 gvm[2][2];
#pragma unroll
        for (int bj = 0; bj < 2; ++bj)
#pragma unroll
            for (int n = 0; n < 2; ++n) gvm[bj][n] = *(const f32x4*)(gate + (size_t)(u.pm >> 3) * NMOD + col0 + bj * HALF + n * 4);
#pragma unroll
        for (int ai = 0; ai < 2; ++ai)
#pragma unroll
            for (int bj = 0; bj < 2; ++bj)
#pragma unroll
                for (int m = 0; m < 4; ++m) { acc[ai][bj][m][0] = acc[ai][bj][m][0] * gvm[bj][0]; acc[ai][bj][m][1] = acc[ai][bj][m][1] * gvm[bj][1]; }
        asm volatile("" ::: "memory");
        f32x4 ivp[2][2], shp[2][2];
        { const float* shr = (const float*)xs + (size_t)(u.pm >> 3) * NMOD + col0;
#pragma unroll
            for (int bj = 0; bj < 2; ++bj)
#pragma unroll
                for (int n = 0; n < 2; ++n) { const int c = bj * HALF + n * 4; const f32x4 gp = *(const f32x4*)((const float*)xp + col0 + c), sc = *(const f32x4*)(shr + DM + c); shp[bj][n] = *(const f32x4*)(shr + c);
                    const f32x4 d = gp * (sc + 1.0f); ivp[bj][n] = (f32x4){inv_scale(d[0]), inv_scale(d[1]), inv_scale(d[2]), inv_scale(d[3])}; } }
#pragma unroll
        for (int am = 0; am < 4; ++am) { const int ai = am >> 1, mb = (am & 1) * 2;
            int frb = fr; asm volatile("" : "+v"(frb));
            u32x4 xr[2][2]; float rnp[2];
#pragma unroll
            for (int mm = 0; mm < 2; ++mm) { const int row = u.pm * BM + ai * HALF + wr * 64 + (mb + mm) * 16 + frb; rnp[mm] = rn[row];
#pragma unroll
                for (int bj = 0; bj < 2; ++bj) xr[mm][bj] = *(const u32x4*)(H + (size_t)row * DM + col0 + bj * HALF); }
#pragma unroll
            for (int mm = 0; mm < 2; ++mm) { const int m = mb + mm, r = ai * HALF + wr * 64 + m * 16 + frb; float ss = 0.f;
#pragma unroll
                for (int bj = 0; bj < 2; ++bj) {
                    const f32x4 b0 = (bf4(xr[mm][bj].x, xr[mm][bj].y) - shp[bj][0]) * ivp[bj][0] * rnp[mm], b1 = (bf4(xr[mm][bj].z, xr[mm][bj].w) - shp[bj][1]) * ivp[bj][1] * rnp[mm];
                    const f32x4 x0 = b0 + acc[ai][bj][m][0], x1 = b1 + acc[ai][bj][m][1]; acc[ai][bj][m][0] = x0; acc[ai][bj][m][1] = x1;
                    ss += (x0[0] * x0[0] + x0[1] * x0[1]) + (x0[2] * x0[2] + x0[3] * x0[3]) + (x1[0] * x1[0] + x1[1] * x1[1]) + (x1[2] * x1[2] + x1[3] * x1[3]); }
                ss += __shfl_xor(ss, 16); ss += __shfl_xor(ss, 32);
                if (fq == 0) P[r * 4 + wc] = ss; }
            asm volatile("" ::: "memory");
        }
        { const int srow = 16 * u.pm + fr; const size_t xo = (size_t)srow * DM + colx; const float* g = gate + (size_t)(NPROMPT + (srow >> 3)) * NMOD + colx; float ss = 0.f;
#pragma unroll
            for (int bj = 0; bj < 2; ++bj) { f32x4 b; const f32x4 gv = *(const f32x4*)(g + bj * HALF);
                { const float* shr = (const float*)xs + (size_t)(NPROMPT + (srow >> 3)) * NMOD + colx + bj * HALF; const u32x2v_ w = *(const u32x2v_*)(H + (size_t)MP * DM + xo + bj * HALF);
                    const f32x4 d = *(const f32x4*)((const float*)xp + colx + bj * HALF) * (*(const f32x4*)(shr + DM) + 1.0f);
                    b = (bf4(w.x, w.y) - *(const f32x4*)shr) * (f32x4){inv_scale(d[0]), inv_scale(d[1]), inv_scale(d[2]), inv_scale(d[3])} * rn[MP + srow]; }
                const f32x4 xn = b + gv * accx[bj]; accx[bj] = xn; ss += (xn[0] * xn[0] + xn[1] * xn[1]) + (xn[2] * xn[2] + xn[3] * xn[3]); }
            ss += __shfl_xor(ss, 16); ss += __shfl_xor(ss, 32);
            if (fq == 0) PX[fr * 8 + wid] = ss; }
        asm volatile("s_waitcnt lgkmcnt(0)" ::: "memory"); __builtin_amdgcn_s_barrier(); asm volatile("" ::: "memory");
        typedef __attribute__((address_space(1))) unsigned long long gu64_;
        gu64_* const gran = (gu64_*)xbuf + (size_t)u.pm * 272 * 4;
        if (tid < 272) { float tot;
            if (tid < 256) tot = (P[tid * 4 + 0] + P[tid * 4 + 1]) + (P[tid * 4 + 2] + P[tid * 4 + 3]);
            else { const PG8_LAS float* q = PX + (tid - 256) * 8; tot = ((q[0] + q[1]) + (q[2] + q[3])) + ((q[4] + q[5]) + (q[6] + q[7])); }
            __hip_atomic_store(gran + tid * 4 + u.pn, ((unsigned long long)epoch << 32) | __builtin_bit_cast(unsigned, tot), __ATOMIC_RELAXED, __HIP_MEMORY_SCOPE_AGENT); }
        typedef unsigned u32x2v __attribute__((ext_vector_type(2)));
        f32x4 ggm[2][2], svm[2][2], cvm[2][2];
        { const float* sh = msh + (size_t)(u.pm >> 3) * NMOD + col0;
#pragma unroll
            for (int bj = 0; bj < 2; ++bj)
#pragma unroll
                for (int n = 0; n < 2; ++n) { const int c = bj * HALF + n * 4; ggm[bj][n] = *(const f32x4*)(ng + col0 + c); svm[bj][n] = *(const f32x4*)(sh + c); cvm[bj][n] = *(const f32x4*)(sh + DM + c) + 1.0f; } }
        if (wid < 5) { const int rr = tid < 272 ? tid : 271; float pv[4];
            for (unsigned spins = 0;;) { bool ok = true;
#pragma unroll
                for (int k = 0; k < 4; ++k) { const unsigned long long x = __hip_atomic_load(gran + rr * 4 + k, __ATOMIC_RELAXED, __HIP_MEMORY_SCOPE_AGENT); pv[k] = __builtin_bit_cast(float, (unsigned)x); ok &= (unsigned)(x >> 32) == epoch; }
                if (__all(ok)) break;
                if (++spins > (1u << 20)) break;
                __builtin_amdgcn_s_sleep(1); }
            if (tid < 272) { const float ms = ((pv[0] + pv[1]) + (pv[2] + pv[3])) * (1.0f / DM) + EPS, rs = 1.0f / sqrtf(ms); S[tid] = rs;
                if (u.pn == 0 && !fin) rn[tid < 256 ? u.pm * BM + tid : MP + 16 * u.pm + (tid - 256)] = ms * rs; } }
        asm volatile("s_waitcnt lgkmcnt(0)" ::: "memory"); __builtin_amdgcn_s_barrier(); asm volatile("" ::: "memory");
#pragma unroll
        for (int ai = 0; ai < 2; ++ai)
#pragma unroll
            for (int m = 0; m < 4; ++m) { const int r = ai * HALF + wr * 64 + m * 16 + fr, row = u.pm * BM + r; const float rstd = S[r];
                float* dst = (float*)out + (size_t)row * DM + col0; bf16_t* hp = H + (size_t)row * DM + col0;
#pragma unroll
                for (int bj = 0; bj < 2; ++bj) { const f32x4 x0 = acc[ai][bj][m][0], x1 = acc[ai][bj][m][1];
                    if (fin) { *(f32x4*)(dst + bj * HALF) = x0 * rstd * ggm[bj][0]; *(f32x4*)(dst + bj * HALF + 4) = x1 * rstd * ggm[bj][1]; }
                    else { const f32x4 h0 = x0 * rstd * ggm[bj][0] * cvm[bj][0] + svm[bj][0], h1 = x1 * rstd * ggm[bj][1] * cvm[bj][1] + svm[bj][1];
                        *(u32x4*)(hp + bj * HALF) = (u32x4){cvt_pk_bf16(h0[0], h0[1]), cvt_pk_bf16(h0[2], h0[3]), cvt_pk_bf16(h1[0], h1[1]), cvt_pk_bf16(h1[2], h1[3])}; } } }
        { const int srow = 16 * u.pm + fr; const float rstd = S[256 + fr];
            const float* sh = msh + (size_t)(NPROMPT + (srow >> 3)) * NMOD + colx; float* dst = (float*)out + (size_t)(MP + srow) * DM + colx; bf16_t* hp = H + (size_t)(MP + srow) * DM + colx;
#pragma unroll
            for (int bj = 0; bj < 2; ++bj) { const int c = bj * HALF; const f32x4 xn = accx[bj]; const f32x4 gg = *(const f32x4*)(ng + colx + c);
                if (fin) *(f32x4*)(dst + c) = xn * rstd * gg;
                else { const f32x4 sv = *(const f32x4*)(sh + c), cv = *(const f32x4*)(sh + DM + c); const f32x4 h = xn * rstd * gg * (cv + 1.0f) + sv;
                    *(u32x2v*)(hp + c) = (u32x2v){cvt_pk_bf16(h[0], h[1]), cvt_pk_bf16(h[2], h[3])}; } } }
    }
};
struct EpiAny {
    static constexpr bool AFTER_DRAIN = false;
    int kind; bool perm; int ldc;
    void *p0, *p1, *p2; const float *f0, *f1, *f2; float* f3; const float *f4, *f5;
    __device__ __forceinline__ void fused(f32x4 (&acc)[2][2][4][2], f32x4 (&accx)[2], const Unit& u, int wr, int wc, int fr, int fq, PG8_LAS unsigned char* lds, int wid, int lane) const {
        EpiResidNorm e{(const void*)f0, (const void*)f1, (void*)f3, f2, (bf16_t*)p0, f4, f5, (float*)p1, (unsigned*)p2, (ldc & 1) != 0, (ldc & 2) != 0, (float*)p1 + (5u << 17), (unsigned)(ldc >> 8) + 1u};
        e.fused(acc, accx, u, wr, wc, fr, fq, lds, wid, lane);
    }
    __device__ __forceinline__ void operator()(const f32x4 (&acc)[2][2][4][2], const f32x4 (&accx)[2], const Unit& u, int wr, int wc, int fr, int fq) const {
        switch (kind) {
            case 0: { EpiF32 e{(float*)p0, ldc, f0}; e(acc, accx, u, wr, wc, fr, fq); } break;
            case 1: { EpiEvenIn e{(bf16_t*)p0, (bf16_t*)p1, (bf16_t*)p2}; e(acc, accx, u, wr, wc, fr, fq); } break;
            case 2: { EpiOddIn e{(bf16_t*)p0, (bf16_t*)p1, f0, f3}; e(acc, accx, u, wr, wc, fr, fq); } break;
            case 3: break;
            case 5: { EpiBBconv e{(const bf16_t*)p1, (bf16_t*)p0, f0, f1}; e(acc, accx, u, wr, wc, fr, fq); } break;
            default: { EpiRelu2 e{(bf16_t*)p0, ldc}; e(acc, accx, u, wr, wc, fr, fq); } break;
        }
    }
};

template <class Epi, class Sched, bool ALIGN_EPI = false, bool SP2 = true>
__device__ __forceinline__ void gemm_phase(PG8_LAS unsigned char* lds, const Gemm g, const Sched& S, const Epi& E) {
    static_assert(SP2, "only the two-super-phase loop is kept");
    int tid_ = threadIdx.x; asm volatile("" : "+v"(tid_));
    const int tid = tid_, wid = __builtin_amdgcn_readfirstlane(tid >> 6), lane = tid & 63, wr = wid >> 2, wc = wid & 3, fr = lane & 15, fq = lane >> 4;
    const int K = g.K, nt = K / BK;
    unsigned voffA, voffB;
    { int R, C; stage_rc(tid * 16, R, C); const int Rb = E.perm ? ((R & ~31) + perm32(R & 31)) : R;
        voffA = (unsigned)(R * K + C) * 2u; voffB = (unsigned)(Rb * K + C) * 2u; }
    const size_t rstep64 = (size_t)64 * K * 2;
    const unsigned voffX = (unsigned)((tid >> 5) * K) * 2u + (unsigned)((((tid & 31) >> 2) ^ ((tid >> 6) & 7)) * 16 + (tid & 3) * 4);
    const size_t kstep = (size_t)(BK * 2);
    const size_t hstep = (size_t)HALF * K * 2;
    const size_t tstep = 2 * hstep;
    const size_t xstep = (size_t)16 * K * 2;
    const unsigned ldsw = (unsigned)wid * 1024u;
    const unsigned ldswx = (unsigned)wid * 256u;
    const int aoff = lds_byte(wr * 64 + fr, fq * 8), boff = lds_byte(wc * 32 + fr, fq * 8), xoff = fr * 128 + ((fq ^ (fr >> 1)) << 4);
#define PG8_SA(b, h) (((b) * 2 + (h)) * HTB)
#define PG8_SB(b, h) ((4 + (b) * 2 + (h)) * HTB)
#define PG8_SX(b) (STAGE_BYTES + (b) * 2048)
#define PG8_STAGE(bufoff, gbase, voff) do { _Pragma("unroll") for (int _i = 0; _i < 2; ++_i) { const char* _p = (const char*)(gbase) + (size_t)_i * rstep64; asm volatile("" : "+s"(_p)); \
        __builtin_amdgcn_global_load_lds((const unsigned*)(_p + (voff)), (PG8_LAS unsigned*)(lds + (bufoff) + ldsw + _i * 8192), 16, 0, 0); } } while (0)
#define PG8_STAGEX(b, gbase) do { const char* _p = (const char*)(gbase); asm volatile("" : "+s"(_p)); \
        __builtin_amdgcn_global_load_lds((const unsigned*)(_p + voffX), (PG8_LAS unsigned*)(lds + PG8_SX(b) + ldswx), 4, 0, 0); } while (0)
#define PG8_LDA(dst, b, h) do { _Pragma("unroll") for (int m = 0; m < 4; ++m) _Pragma("unroll") for (int k = 0; k < 2; ++k) dst[m][k] = *(const PG8_LAS bf16x8*)(lds + PG8_SA(b, h) + aoff + m * 2048 + k * 1024); } while (0)
#define PG8_LDB(dst, b, h) do { _Pragma("unroll") for (int n = 0; n < 2; ++n) _Pragma("unroll") for (int k = 0; k < 2; ++k) dst[n][k] = *(const PG8_LAS bf16x8*)(lds + PG8_SB(b, h) + boff + n * 2048 + k * 1024); } while (0)
#define PG8_LDX(dst, b) do { _Pragma("unroll") for (int k = 0; k < 2; ++k) dst[k] = *(const PG8_LAS bf16x8*)(lds + PG8_SX(b) + (xoff ^ (k * 64))); } while (0)
#define PG8_MMA(ai, bj, At, Bt) do { __builtin_amdgcn_s_setprio(1); _Pragma("unroll") for (int m = 0; m < 4; ++m) _Pragma("unroll") for (int n = 0; n < 2; ++n) _Pragma("unroll") for (int k = 0; k < 2; ++k) \
        acc[ai][bj][m][n] = __builtin_amdgcn_mfma_f32_16x16x32_bf16(Bt[n][k], At[m][k], acc[ai][bj][m][n], 0, 0, 0); __builtin_amdgcn_s_setprio(0); } while (0)
#define PG8_MMAX(Xt) do { if (wr == 0) { _Pragma("unroll") for (int k = 0; k < 2; ++k) { accx[0] = __builtin_amdgcn_mfma_f32_16x16x32_bf16(B0[0][k], Xt[k], accx[0], 0, 0, 0); accx[1] = __builtin_amdgcn_mfma_f32_16x16x32_bf16(B1[0][k], Xt[k], accx[1], 0, 0, 0); } } \
        else { _Pragma("unroll") for (int k = 0; k < 2; ++k) { accx[0] = __builtin_amdgcn_mfma_f32_16x16x32_bf16(B0[1][k], Xt[k], accx[0], 0, 0, 0); accx[1] = __builtin_amdgcn_mfma_f32_16x16x32_bf16(B1[1][k], Xt[k], accx[1], 0, 0, 0); } } } while (0)
#define PG8_WAIT_V(n) asm volatile("s_waitcnt vmcnt(" #n ")" ::: "memory")
#define PG8_WAIT_L(n) asm volatile("s_waitcnt lgkmcnt(" #n ")" ::: "memory")
#define PG8_BAR __builtin_amdgcn_s_barrier()
#define PG8_SCHED __builtin_amdgcn_sched_barrier(0)
    Unit cur, nxt; int ui = 0;
    if (!S.next(0, cur)) return;
    f32x4 acc[2][2][4][2]; f32x4 accx[2];
#pragma unroll
    for (int a = 0; a < 2; ++a)
#pragma unroll
        for (int b = 0; b < 2; ++b)
#pragma unroll
            for (int m = 0; m < 4; ++m)
#pragma unroll
                for (int n = 0; n < 2; ++n) acc[a][b][m][n] = (f32x4){0.f, 0.f, 0.f, 0.f};
    accx[0] = (f32x4){0.f, 0.f, 0.f, 0.f}; accx[1] = (f32x4){0.f, 0.f, 0.f, 0.f};
    bf16x8 At[4][2], B0[2][2], B1[2][2], Xt[2];
    const char* cA = (const char*)g.A + (size_t)cur.pm * tstep; const char* cB = (const char*)g.Bt + (size_t)cur.pn * tstep; const char* cX = (const char*)g.AX + (size_t)cur.pm * xstep;
    S.a_ready(cur);
    PG8_STAGE(PG8_SB(0, 0), cB, voffB); PG8_STAGE(PG8_SB(0, 1), cB + hstep, voffB); PG8_STAGE(PG8_SA(0, 0), cA, voffA); PG8_STAGE(PG8_SA(0, 1), cA + hstep, voffA); PG8_STAGEX(0, cX);
    if (wr == 1) PG8_BAR;
    PG8_WAIT_V(3); PG8_BAR;
    PG8_STAGE(PG8_SB(1, 0), cB + kstep, voffB); PG8_STAGE(PG8_SA(1, 0), cA + kstep, voffA); PG8_STAGE(PG8_SB(1, 1), cB + hstep + kstep, voffB);
    PG8_WAIT_V(6); PG8_BAR;
    for (;;) {
        const bool has_next = S.next(ui + 1, nxt);
        const char* nA = has_next ? (const char*)g.A + (size_t)nxt.pm * tstep : cA; const char* nB = has_next ? (const char*)g.Bt + (size_t)nxt.pn * tstep : cB;
        const char* nX = has_next ? (const char*)g.AX + (size_t)nxt.pm * xstep : cX;
        for (int t = 0; t < nt; t += 2) {
            const bool last = (t == nt - 2);
            const bool relax = (t == 0) && (ui > 0) && (E.kind == 4);
            const char* a1 = cA + (size_t)(t + 1) * kstep; const char* x1 = cX + (size_t)(t + 1) * kstep;
            const char* a2 = last ? nA : cA + (size_t)(t + 2) * kstep; const char* b2 = last ? nB : cB + (size_t)(t + 2) * kstep;
            const char* x2 = last ? nX : cX + (size_t)(t + 2) * kstep;
            const char* a3 = a2 + kstep; const char* b3 = b2 + kstep;
            if (last && has_next) S.a_ready(nxt);
            PG8_LDB(B0, 0, 0); PG8_LDB(B1, 0, 1); PG8_SCHED; PG8_LDA(At, 0, 0); PG8_STAGE(PG8_SA(1, 1), a1 + hstep, voffA); PG8_STAGEX(1, x1);
            if (relax) PG8_WAIT_V(27); else PG8_WAIT_V(9);
            PG8_WAIT_L(0); PG8_BAR; PG8_MMA(0, 0, At, B0); PG8_MMA(0, 1, At, B1); PG8_BAR; PG8_SCHED;
            PG8_LDA(At, 0, 1); PG8_LDX(Xt, 0); PG8_STAGE(PG8_SB(0, 0), b2, voffB); PG8_STAGE(PG8_SB(0, 1), b2 + hstep, voffB); PG8_STAGE(PG8_SA(0, 0), a2, voffA);
            if (relax) PG8_WAIT_V(27); else PG8_WAIT_V(9);
            PG8_WAIT_L(0); PG8_BAR; PG8_MMA(1, 0, At, B0); PG8_MMA(1, 1, At, B1); PG8_MMAX(Xt); PG8_BAR; PG8_SCHED;
            PG8_LDB(B0, 1, 0); PG8_LDB(B1, 1, 1); PG8_SCHED; PG8_LDA(At, 1, 0); PG8_STAGE(PG8_SA(0, 1), a2 + hstep, voffA); PG8_STAGEX(0, x2);
            PG8_WAIT_V(9); PG8_WAIT_L(0); PG8_BAR; PG8_MMA(0, 0, At, B0); PG8_MMA(0, 1, At, B1); PG8_BAR; PG8_SCHED;
            PG8_LDA(At, 1, 1); PG8_LDX(Xt, 1); PG8_STAGE(PG8_SB(1, 0), b3, voffB); PG8_STAGE(PG8_SB(1, 1), b3 + hstep, voffB); PG8_STAGE(PG8_SA(1, 0), a3, voffA);
            PG8_WAIT_V(9); PG8_WAIT_L(0); PG8_BAR; PG8_MMA(1, 0, At, B0); PG8_MMA(1, 1, At, B1); PG8_MMAX(Xt); PG8_BAR; PG8_SCHED;
        }
        if constexpr (ALIGN_EPI) { if (wr == 0) PG8_BAR; }
        { int fr_ = fr, fq_ = fq; asm volatile("" : "+v"(fr_), "+v"(fq_));
          if (E.kind != 3) E(acc, accx, cur, wr, wc, fr_, fq_); } S.done(cur);
        if (!has_next) break;
#pragma unroll
        for (int a = 0; a < 2; ++a)
#pragma unroll
            for (int b = 0; b < 2; ++b)
#pragma unroll
                for (int m = 0; m < 4; ++m)
#pragma unroll
                    for (int n = 0; n < 2; ++n) acc[a][b][m][n] = (f32x4){0.f, 0.f, 0.f, 0.f};
        accx[0] = (f32x4){0.f, 0.f, 0.f, 0.f}; accx[1] = (f32x4){0.f, 0.f, 0.f, 0.f};
        cur = nxt; cA = nA; cB = nB; cX = nX; ++ui;
        if constexpr (ALIGN_EPI) { if (wr == 1) PG8_BAR; }
    }
    PG8_WAIT_V(0);
    if constexpr (!ALIGN_EPI) { if (wr == 0) PG8_BAR; }
    PG8_BAR;
    if (E.kind == 3) { int fr_ = fr, fq_ = fq, ln_ = lane; asm volatile("" : "+v"(fr_), "+v"(fq_), "+v"(ln_)); E.fused(acc, accx, cur, wr, wc, fr_, fq_, lds, wid, ln_); }
#undef PG8_SA
#undef PG8_SB
#undef PG8_SX
#undef PG8_STAGE
#undef PG8_STAGEX
#undef PG8_LDA
#undef PG8_LDB
#undef PG8_LDX
#undef PG8_MMA
#undef PG8_MMAX
#undef PG8_WAIT_V
#undef PG8_WAIT_L
#undef PG8_BAR
#undef PG8_SCHED
}
}
#ifndef PG8_SP2
#define PG8_SP2 true
#endif
#ifndef PG8_ALIGN
#define PG8_ALIGN true
#endif

constexpr int NWAVES = 8;
constexpr int N_PHASES = 23;

constexpr size_t OUT_Y = 0;
constexpr size_t OUT_CA_P = (size_t)MT * DM;
constexpr size_t OUT_CA_S = OUT_CA_P + 2 * 8 * 30 * 512;
constexpr size_t OUT_CB_P = OUT_CA_S + 2 * 128 * 30 * 512;
constexpr size_t OUT_CB_S = OUT_CB_P + 2 * 8 * 2 * 512;
constexpr size_t OUT_CV_P = OUT_CB_S + 2 * 128 * 2 * 512;
constexpr size_t OUT_CV_S = OUT_CV_P + 2 * 8 * 128 * 1024;
constexpr size_t OUT_END = OUT_CV_S + 2 * 128 * 8 * 1024;
static_assert(OUT_END == 26476544, "d_out map");

constexpr size_t MiB = 1u << 20;
constexpr size_t WS_CTL = 0, CTL_ZERO_BYTES = 32 * 1024;
constexpr size_t WS_WINAB = 2 * MiB;
constexpr size_t WS_WOUTAB = 12 * MiB;
constexpr size_t WS_WINC = 16 * MiB;
constexpr size_t WS_WOUTC = 24 * MiB;
constexpr size_t WS_WFF1 = 28 * MiB;
constexpr size_t WS_WFF2 = 60 * MiB;
constexpr size_t WS_WADA = 92 * MiB;
constexpr size_t WS_CACT = 140 * MiB;
constexpr size_t WS_MOD = 141 * MiB;
constexpr size_t WS_STAT = 165 * MiB;
constexpr size_t WS_H = 168 * MiB;
constexpr size_t WS_BIG = 202 * MiB;
constexpr size_t WS_XBUF = 338 * MiB;
constexpr size_t WS_XB = 341 * MiB;
constexpr size_t WS_END = 375 * MiB;
constexpr size_t BIG_AG = 0, BIG_BX = 17 * MiB, BIG_BB = 34 * MiB, BIG_AB = 51 * MiB;
constexpr size_t BIG_U = 0, BIG_V = 34 * MiB, BIG_US = 68 * MiB;
static_assert((size_t)MT * DFF * 2 == 136 * MiB && (size_t)MT * DM * 2 == 34 * MiB && (size_t)MT * 512 * 2 == 17 * MiB, "sizes");
constexpr int XCD_BAR_WORDS_ = 3456; constexpr int CW_BAR = 1024;
constexpr int CW_SEAM = 8192;
static_assert((CW_BAR + XCD_BAR_WORDS_) * 4 <= (int)CTL_ZERO_BYTES, "barrier words inside the memset region");

constexpr int RING_OFF = 0, RING_BYTES = 131072;
constexpr int SLAB_BYTES = 4096;
constexpr int LDSCTL_OFF = RING_BYTES + SLAB_BYTES, MISC_OFF = LDSCTL_OFF + 320;
constexpr int LDS_BYTES = 147456;

#define GAS __attribute__((address_space(1)))
#define LAS __attribute__((address_space(3)))
typedef unsigned short bf16;
typedef unsigned v4u __attribute__((ext_vector_type(4)));
typedef unsigned v2u __attribute__((ext_vector_type(2)));
typedef float f32x4 __attribute__((ext_vector_type(4)));
typedef float f32x2 __attribute__((ext_vector_type(2)));
typedef short bf16x8 __attribute__((ext_vector_type(8)));
typedef GAS unsigned gu32;
#define RLX_AGENT __ATOMIC_RELAXED, __HIP_MEMORY_SCOPE_AGENT
#define LDS_WAIT() asm volatile("s_waitcnt lgkmcnt(0)" ::: "memory")
#define VM_WAIT() asm volatile("s_waitcnt vmcnt(0)" ::: "memory")
__device__ __forceinline__ unsigned f2bf(float f) { unsigned u = __builtin_bit_cast(unsigned, f); return (u + 0x7fffu + ((u >> 16) & 1u)) >> 16; }
__device__ __forceinline__ unsigned pk2(float lo, float hi) { return pg8::cvt_pk_bf16(lo, hi); }
__device__ __forceinline__ float bf2f(unsigned short b) { return __builtin_bit_cast(float, (unsigned)b << 16); }
__device__ __forceinline__ float bflo(unsigned w) { return __builtin_bit_cast(float, w << 16); }
__device__ __forceinline__ float bfhi(unsigned w) { return __builtin_bit_cast(float, w & 0xffff0000u); }
__device__ __forceinline__ float silu_f(float x) { return x * __builtin_amdgcn_rcpf(1.0f + __expf(-x)); }

#define XB_TMO      128
#define XB_XCNT(j)  (256  + 64 * (j))
#define XB_XSUB(j)  (1280 + 64 * (j))
#define XB_XGEN(j)  (2304 + 64 * (j))
#define XB_TOP      3328
#define XB_TOPGEN   3392
#define XCD_BAR_WORDS 3456
#define XB_SPIN_CAP (1u << 18)

__device__ __forceinline__ unsigned xb_ld(unsigned* p)              { return __hip_atomic_load(p, __ATOMIC_RELAXED, __HIP_MEMORY_SCOPE_AGENT); }
__device__ __forceinline__ unsigned xb_add(unsigned* p, unsigned v) { return __hip_atomic_fetch_add(p, v, __ATOMIC_RELAXED, __HIP_MEMORY_SCOPE_AGENT); }
__device__ __forceinline__ unsigned xb_xcc_id() { return (unsigned)__builtin_amdgcn_s_getreg((3 << 11) | 20) & 0xFu; }
#define XB_SPIN(cond, bar) do { unsigned _sp = 0; while (cond) { __builtin_amdgcn_s_sleep(1); \
    if ((++_sp & 255u) == 0u) { if (xb_ld(&(bar)[XB_TMO])) break; if (_sp > XB_SPIN_CAP) { atomicAdd(&(bar)[XB_TMO], 1u); break; } } } } while (0)

struct XcdBarrier {
    unsigned* bar; unsigned x;
    volatile LAS unsigned* st;
};

__device__ __forceinline__ XcdBarrier xcd_barrier_post(unsigned* bar, volatile LAS unsigned* st) {
    XcdBarrier b; b.bar = bar; b.x = xb_xcc_id(); b.st = st;
    if (threadIdx.x == 0) (void)xb_add(&bar[XB_XCNT(b.x)], 1u);
    return b;
}
__device__ __forceinline__ void xcd_barrier_complete(unsigned* bar, unsigned x, unsigned& nloc, unsigned& nx) {
    const unsigned G = gridDim.x * gridDim.y * gridDim.z;
    unsigned sum, cnt, mine, sp = 0u;
    for (;;) {
        sum = 0u; cnt = 0u; mine = 0u;
#pragma unroll
        for (unsigned j = 0; j < 16; ++j) { const unsigned c = xb_ld(&bar[XB_XCNT(j)]); sum += c; cnt += (c > 0u) ? 1u : 0u; mine = (j == x) ? c : mine; }
        if (sum == G) break;
        __builtin_amdgcn_s_sleep(1);
        if ((++sp & 255u) == 0u) { if (xb_ld(&bar[XB_TMO])) break; if (sp > XB_SPIN_CAP) { atomicAdd(&bar[XB_TMO], 1u); break; } }
    }
    nloc = mine > 0u ? mine : 1u; nx = cnt > 0u ? cnt : 1u;
}

__device__ __forceinline__ void xcd_barrier(const XcdBarrier& b) {
    asm volatile("s_waitcnt vmcnt(0)" ::: "memory");
    __syncthreads();
    if (threadIdx.x == 0) {
        unsigned* bar = b.bar;
        __builtin_amdgcn_s_waitcnt(0);
        unsigned nloc = b.st[0], nx = b.st[1];
        if (nloc == 0u) { xcd_barrier_complete(bar, b.x, nloc, nx); b.st[0] = nloc; b.st[1] = nx; }
        const unsigned old = xb_add(&bar[XB_XSUB(b.x)], 1u);
        const unsigned gen = old / nloc;
        if (old + 1u == (gen + 1u) * nloc) {
            __builtin_amdgcn_fence(__ATOMIC_RELEASE, "agent");
            asm volatile("s_waitcnt vmcnt(0)" ::: "memory");
            const unsigned og = xb_add(&bar[XB_TOP], 1u);
            const unsigned tg = og / nx;
            if (og + 1u == (tg + 1u) * nx) xb_add(&bar[XB_TOPGEN], 1u);
            else XB_SPIN(xb_ld(&bar[XB_TOPGEN]) == tg, bar);
            __builtin_amdgcn_fence(__ATOMIC_ACQUIRE, "agent");
            xb_add(&bar[XB_XGEN(b.x)], 1u);
            asm volatile("s_waitcnt vmcnt(0)" ::: "memory");
        } else {
            XB_SPIN(xb_ld(&bar[XB_XGEN(b.x)]) == gen, bar);
            __builtin_amdgcn_fence(__ATOMIC_ACQUIRE, "agent");
            asm volatile("s_waitcnt vmcnt(0)" ::: "memory");
        }
    }
    __syncthreads();
}
struct Args { const float* in[26]; float* out; unsigned char* ws; int ph_lo, ph_hi, li, pad; };
#define INP(i) (args.in[(i) + F.z])
struct Frame {
    LAS unsigned char* lds;
    volatile LAS unsigned* MISC;
    gu32* ctl;
    int tid, lane, wave, G, bid;
    int z;
    float* out;
    unsigned char* ws;
};
__device__ __forceinline__ float wave_sum(float v, int lane) {
    (void)lane;
#pragma unroll
    for (int o = 1; o < 64; o <<= 1) v += __shfl_xor(v, o);
    return v;
}

__device__ __forceinline__ void p0_transpose_item(const float* W, int K, int N, bf16* WT, int k0, int n0, int drow0, LAS float* scr, int lane) {
    f32x4 v[8];
#pragma unroll
    for (int i = 0; i < 8; ++i) { const int q = lane + 64 * i; v[i] = __builtin_nontemporal_load((const f32x4*)(W + (size_t)(k0 + (q >> 3)) * N + n0 + 4 * (q & 7))); }
#pragma unroll
    for (int i = 0; i < 8; ++i) { const int q = lane + 64 * i; LAS float* d = scr + (q >> 3) * 33 + 4 * (q & 7); d[0] = v[i].x; d[1] = v[i].y; d[2] = v[i].z; d[3] = v[i].w; }
    LDS_WAIT(); asm volatile("" ::: "memory");
    const int c = lane & 7;
#pragma unroll
    for (int j = 0; j < 4; ++j) { const int n = (lane >> 3) + 8 * j; const LAS float* s = scr + (8 * c) * 33 + n;
        v4u o; o.x = pk2(s[0 * 33], s[1 * 33]); o.y = pk2(s[2 * 33], s[3 * 33]); o.z = pk2(s[4 * 33], s[5 * 33]); o.w = pk2(s[6 * 33], s[7 * 33]);
        *(GAS v4u*)(WT + (size_t)(drow0 + n) * K + k0 + 8 * c) = o; }
    LDS_WAIT(); asm volatile("" ::: "memory");
}
__device__ __forceinline__ int even_in_row(int c) {
    const int seg = c >> 9, r = c & 511, q = r >> 7, j = r & 127;
    if (seg == 0) return 256 * q + j;
    if (seg == 1) return 256 * q + 128 + j;
    if (seg == 2) return 1024 + 256 * q + j;
    if (seg == 4) return 1024 + 256 * q + 128 + j;
    return 2048 + r;
}
template <bool DEFERRED>
__device__ __forceinline__ void p0_items(Frame& F, const Args& args, int gw, int NGW) {
    LAS float* scr = (LAS float*)(F.lds + RING_OFF + F.wave * 16384);
    constexpr int I_INAB = 16 * 80, I_OUT = 16 * 32, I_INC = 16 * 64, I_FF1 = 16 * 128, I_FF2 = 64 * 32, I_ADA = 16 * 192;
    constexpr int T0 = 0, T1 = T0 + 2 * I_INAB, T2 = T1 + 2 * I_OUT, T3 = T2 + 2 * I_INC, T4 = T3 + 2 * I_OUT, T5 = T4 + 4 * I_FF1, T6 = T5 + 4 * I_FF2, T7 = T6 + 4 * I_ADA;
    constexpr int NDEF = T7 - 13 * 2048, D0 = T6 - NDEF;
    for (int i = gw; i < (DEFERRED ? NDEF : T7 - NDEF); i += NGW) {
        int it;
        if (DEFERRED) it = D0 + i;
        else { constexpr int NADA = T7 - T6, NFF1 = D0 - T4; it = i < NADA ? T6 + i : (i - NADA < NFF1 ? T4 + (i - NADA) : i - NADA - NFF1); }
        const float* W; bf16* WT; int K, N, r, per; bool perm = false;
        if (it < T1)      { r = it - T0; per = I_INAB; K = 1024; N = 2560; W = INP(6);  WT = (bf16*)(F.ws + WS_WINAB);  perm = true; }
        else if (it < T2) { r = it - T1; per = I_OUT;  K = 1024; N = 1024; W = INP(12); WT = (bf16*)(F.ws + WS_WOUTAB); }
        else if (it < T3) { r = it - T2; per = I_INC;  K = 1024; N = 2048; W = INP(13); WT = (bf16*)(F.ws + WS_WINC); }
        else if (it < T4) { r = it - T3; per = I_OUT;  K = 1024; N = 1024; W = INP(19); WT = (bf16*)(F.ws + WS_WOUTC); }
        else if (it < T5) { r = it - T4; per = I_FF1;  K = 1024; N = 4096; W = INP(23); WT = (bf16*)(F.ws + WS_WFF1); }
        else if (it < T6) { r = it - T5; per = I_FF2;  K = 4096; N = 1024; W = INP(24); WT = (bf16*)(F.ws + WS_WFF2); }
        else              { r = it - T6; per = I_ADA;  K = 1024; N = 6144; W = INP(20); WT = (bf16*)(F.ws + WS_WADA); }
        const int layer = r / per, item = r % per; W += (size_t)layer * K * N; WT += (size_t)layer * K * N;
        const int nblk = N / 32, kb = item / nblk, nb = item % nblk, k0 = 64 * kb, n0 = 32 * nb;
        p0_transpose_item(W, K, N, WT, k0, n0, perm ? even_in_row(n0) : n0, scr, F.lane);
    }
}
__device__ __forceinline__ void p0_prologue(Frame& F, const Args& args) {
    { unsigned long long* gz = (unsigned long long*)(F.ws + WS_XBUF);
      for (int i = F.bid * (NWAVES * 64) + F.tid; i < 64 * 272 * 4; i += F.G * NWAVES * 64) gz[i] = 0ull; }
    p0_items<false>(F, args, F.bid * NWAVES + F.wave, F.G * NWAVES);
    bf16* cact = (bf16*)(F.ws + WS_CACT);
    for (int idx = F.bid * (NWAVES * 64) + F.tid; idx < 256 * DM; idx += F.G * NWAVES * 64) {
        const int row = idx >> 10, col = idx & 1023; float v = 0.f;
        if (row < NPROMPT) v = silu_f(INP(4)[row * DM + col]); else if (row < NSEQ) v = silu_f(INP(5)[(row - NPROMPT) * DM + col]);
        cact[idx] = (bf16)f2bf(v);
    }
}

__device__ __forceinline__ void norm_phase(Frame& F, const Args& args, const float* xp, const float* xs, const float* g, const float* msh, const float* msc, bf16* H) {
    const int gw = F.bid * NWAVES + F.wave, NGW = F.G * NWAVES;
    const GAS f32x4* g4 = (const GAS f32x4*)g + F.lane;
    for (int row = gw; row < MT; row += NGW) {
        const float* src = row < MP ? xp + (size_t)row * DM : xs + (size_t)(row - MP) * DM;
        const GAS f32x4* xr = (const GAS f32x4*)src + F.lane;
        const int sq = seq_of_row(row);
        const GAS f32x4* sh4 = (const GAS f32x4*)(msh + (size_t)sq * NMOD) + F.lane; const GAS f32x4* sc4 = (const GAS f32x4*)(msc + (size_t)sq * NMOD) + F.lane;
        f32x4 v[4]; float ss = 0.f;
#pragma unroll
        for (int j = 0; j < 4; ++j) { v[j] = __builtin_nontemporal_load(xr + (j >> 1) * 128 + F.lane + (j & 1)); ss += (v[j].x * v[j].x + v[j].y * v[j].y) + (v[j].z * v[j].z + v[j].w * v[j].w); }
        const float ms0 = wave_sum(ss, F.lane) * (1.0f / DM) + EPS, rstd = 1.0f / sqrtf(ms0);
        if (F.lane == 0) ((float*)(F.ws + WS_XBUF) + (5u << 17))[row] = ms0 * rstd;
        f32x4 h[4];
#pragma unroll
        for (int j = 0; j < 4; ++j) { const int o4 = (j >> 1) * 128 + F.lane + (j & 1); const f32x4 gg = g4[o4], sc = sc4[o4], sh = sh4[o4]; h[j] = v[j] * rstd * gg * (sc + 1.0f) + sh; }
        GAS v4u* o16 = (GAS v4u*)(H + (size_t)row * DM) + F.lane;
        o16[0] = (v4u){pk2(h[0].x, h[0].y), pk2(h[0].z, h[0].w), pk2(h[1].x, h[1].y), pk2(h[1].z, h[1].w)};
        o16[64] = (v4u){pk2(h[2].x, h[2].y), pk2(h[2].z, h[2].w), pk2(h[3].x, h[3].y), pk2(h[3].z, h[3].w)};
    }
}
__device__ __forceinline__ void final_norm_phase(Frame& F, const Args& args, float* x, const float* g) {
    const int gw = F.bid * NWAVES + F.wave, NGW = F.G * NWAVES;
    const GAS f32x4* g4 = (const GAS f32x4*)g + F.lane;
    for (int row = gw; row < MT; row += NGW) {
        GAS f32x4* xr = (GAS f32x4*)(x + (size_t)row * DM) + F.lane;
        f32x4 v[4]; float ss = 0.f;
#pragma unroll
        for (int j = 0; j < 4; ++j) { v[j] = xr[64 * j]; ss += (v[j].x * v[j].x + v[j].y * v[j].y) + (v[j].z * v[j].z + v[j].w * v[j].w); }
        const float rstd = 1.0f / sqrtf(wave_sum(ss, F.lane) * (1.0f / DM) + EPS);
#pragma unroll
        for (int j = 0; j < 4; ++j) xr[64 * j] = v[j] * rstd * g4[64 * j];
    }
}

template <int R, bool SAMPLE>
__device__ __forceinline__ void even_prep_item(Frame& F, const Args& args, int e, int rowbase, int t0, int sidx) {
    const bf16* AG = (const bf16*)(F.ws + WS_BIG + BIG_AG); const bf16* BX = (const bf16*)(F.ws + WS_BIG + BIG_BX);
    bf16* AB = (bf16*)(F.ws + WS_BIG + BIG_AB);
    LAS float* CO = (LAS float*)(F.lds + RING_OFF);
    const int c = F.tid;
    const f32x4 g0 = *(const f32x4*)(INP(9) + e * DA + 4 * F.lane), g1 = *(const f32x4*)(INP(9) + e * DA + 256 + 4 * F.lane);
    const f32x4 b0 = *(const f32x4*)(INP(10) + e * DA + 4 * F.lane), b1 = *(const f32x4*)(INP(10) + e * DA + 256 + 4 * F.lane);
    float bx[R + 2];
    if (SAMPLE) {
        const float* st = INP(3) + ((size_t)(e * NSAMP + sidx) * 2) * DA + c;
        bx[0] = st[0]; bx[1] = st[DA];
#pragma unroll
        for (int j = 0; j < R; ++j) bx[2 + j] = bf2f(BX[(size_t)(rowbase + j) * DA + c]);
    } else {
#pragma unroll
        for (int j = 0; j < R + 2; ++j) { const int t = t0 - 2 + j; const int rr = rowbase - 2 + j + (t < 0 ? -t : 0);
            const float v = bf2f(BX[(size_t)rr * DA + c]); bx[j] = t < 0 ? 0.f : v; }
    }
    {
        float in[R + 30];
        if (SAMPLE) {
            const float* st = INP(2) + ((size_t)(e * NSAMP + sidx) * 30) * DA + c;
#pragma unroll
            for (int j = 0; j < 30; ++j) in[j] = st[(size_t)j * DA];
#pragma unroll
            for (int j = 0; j < R; ++j) in[30 + j] = bf2f(AG[(size_t)(rowbase + j) * DA + c]);
        } else {
#pragma unroll
            for (int j = 0; j < R + 30; ++j) { const int t = t0 - 30 + j; const int rr = rowbase - 30 + j + (t < 0 ? -t : 0);
                const float v = bf2f(AG[(size_t)rr * DA + c]); in[j] = t < 0 ? 0.f : v; }
        }
        float w[31];
#pragma unroll
        for (int k = 0; k < 31; ++k) w[k] = INP(7)[(size_t)(e * 31 + k) * DA + c];
        const float bias = INP(8)[e * DA + c];
#pragma unroll
        for (int t = 0; t < R; ++t) { float a = bias;
#pragma unroll
            for (int k = 0; k < 31; ++k) a = fmaf(w[k], in[t + k], a);
            CO[t * DA + c] = a; }
        if (SAMPLE) { float* o = F.out + OUT_CA_S + ((size_t)(e * NSAMP + sidx) * 30) * DA + c;
#pragma unroll
            for (int j = 0; j < 30; ++j) o[(size_t)j * DA] = in[R + j];
        } else if (t0 == SEQ - R) { float* o = F.out + OUT_CA_P + ((size_t)(e * NPROMPT + sidx) * 30) * DA + c;
#pragma unroll
            for (int j = 0; j < 30; ++j) o[(size_t)j * DA] = in[R + j]; }
    }
    __syncthreads();
    {
        for (int t = F.wave; t < R; t += NWAVES) {
            const f32x4 x0 = *(const LAS f32x4*)(CO + t * DA + 4 * F.lane), x1 = *(const LAS f32x4*)(CO + t * DA + 256 + 4 * F.lane);
            const float mean = wave_sum((x0.x + x0.y) + (x0.z + x0.w) + (x1.x + x1.y) + (x1.z + x1.w), F.lane) * (1.0f / DA);
            const f32x4 d0 = x0 - mean, d1 = x1 - mean;
            const float var = wave_sum((d0.x * d0.x + d0.y * d0.y) + (d0.z * d0.z + d0.w * d0.w) + (d1.x * d1.x + d1.y * d1.y) + (d1.z * d1.z + d1.w * d1.w), F.lane) * (1.0f / DA);
            const float rstd = 1.0f / sqrtf(var + EPS);
            f32x4 y0 = d0 * rstd * g0 + b0, y1 = d1 * rstd * g1 + b1;
#pragma unroll
            for (int i = 0; i < 4; ++i) { y0[i] = silu_f(y0[i]); y1[i] = silu_f(y1[i]); }
            bf16* o = AB + (size_t)(rowbase + t) * DM + 4 * F.lane;
            *(GAS v2u*)o = (v2u){pk2(y0.x, y0.y), pk2(y0.z, y0.w)}; *(GAS v2u*)(o + 256) = (v2u){pk2(y1.x, y1.y), pk2(y1.z, y1.w)};
        }
    }
    {
        if (SAMPLE) { float* o = F.out + OUT_CB_S + ((size_t)(e * NSAMP + sidx) * 2) * DA + c; o[0] = bx[R]; o[DA] = bx[R + 1]; }
        else if (t0 == SEQ - R) { float* o = F.out + OUT_CB_P + ((size_t)(e * NPROMPT + sidx) * 2) * DA + c; o[0] = bx[R]; o[DA] = bx[R + 1]; }
    }
    __syncthreads();
}
struct EvTa { v4u ta[8]; };
__device__ __forceinline__ void even_item_load_ta(Frame& F, int tid, int rowbase, EvTa& L) {
    const bf16* AG = (const bf16*)(F.ws + WS_BIG + BIG_AG); const bool first = (rowbase & (SEQ - 1)) == 0;
#pragma unroll
    for (int i = 0; i < 8; ++i) { const int q = tid + 512 * i, j = q >> 6, ch = q & 63; const bool inr = q < 62 * 64, ok = inr && (!first || j >= 30);
        const v4u v = *(const GAS v4u*)(AG + (size_t)(rowbase + (ok ? j - 30 : 0)) * DA + 8 * ch); L.ta[i] = ok ? v : (v4u){0u, 0u, 0u, 0u}; }
}
__device__ __forceinline__ void even_prep_light(Frame& F, const Args& args, int e) {
    constexpr int RP = 32, NIP = MP / RP, LW0 = 128, LWN = 128;
    const bf16* BX = (const bf16*)(F.ws + WS_BIG + BIG_BX); bf16* AB = (bf16*)(F.ws + WS_BIG + BIG_AB);
    LAS unsigned char* TA = F.lds + RING_OFF; LAS float* CO = (LAS float*)(F.lds + RING_OFF + 62 * 1024);
    const int c = F.tid, cg = F.tid & 63, rb = F.tid >> 6;
    const int lw = F.bid - LW0;
    if (lw < 0) { if (F.bid < NSAMP) { const int sq = (F.bid & 7) * 16 + (F.bid >> 3); even_prep_item<DSEQ, true>(F, args, e, MP + sq * DSEQ, 0, sq); } return; }
    int it = 64 * (F.bid & 7) + (lw >> 3);
    {
        float w[31];
#pragma unroll
        for (int k = 0; k < 31; ++k) w[k] = INP(7)[(size_t)(e * 31 + k) * DA + c];
        const float bias = INP(8)[e * DA + c];
        const f32x4 g0 = *(const f32x4*)(INP(9) + e * DA + 8 * F.lane), g1 = *(const f32x4*)(INP(9) + e * DA + 8 * F.lane + 4);
        const f32x4 b0 = *(const f32x4*)(INP(10) + e * DA + 8 * F.lane), b1 = *(const f32x4*)(INP(10) + e * DA + 8 * F.lane + 4);
        EvTa cur;
#pragma unroll 1
        for (int k4 = 0; k4 < 4; ++k4, it += 16) {
            const int rowbase = it * RP, t0 = rowbase & (SEQ - 1), b = rowbase >> 11; const bool lastit = t0 == SEQ - 32;
            int tv = F.tid; asm volatile("" : "+v"(tv));
            const int c = tv, cg = tv & 63, rb = tv >> 6, ln = tv & 63;
            even_item_load_ta(F, tv, it * RP, cur);
#pragma unroll
            for (int i = 0; i < 8; ++i) { const int q = tv + 512 * i; if (q < 62 * 64) *(LAS v4u*)(TA + (q >> 6) * 1024 + (q & 63) * 16) = cur.ta[i]; }
            __syncthreads();
#pragma unroll
            for (int hh = 0; hh < 2; ++hh) {
                float in[46];
#pragma unroll
                for (int j = 0; j < 46; ++j) in[j] = bf2f(*(const LAS unsigned short*)(TA + (16 * hh + j) * 1024 + c * 2));
#pragma unroll
                for (int t = 0; t < 16; ++t) { float a = bias;
#pragma unroll
                    for (int k = 0; k < 31; ++k) a = fmaf(w[k], in[t + k], a);
                    CO[(16 * hh + t) * DA + c] = a; }
                if (hh == 1 && lastit) { float* o = F.out + OUT_CA_P + ((size_t)(e * NPROMPT + b) * 30) * DA + c;
#pragma unroll
                    for (int j = 0; j < 30; ++j) o[(size_t)j * DA] = in[16 + j]; }
            }
            __syncthreads();
#pragma unroll
            for (int tt = 0; tt < 4; ++tt) { const int t = F.wave + 8 * tt;
                const f32x4 x0 = *(const LAS f32x4*)(CO + t * DA + 8 * ln), x1 = *(const LAS f32x4*)(CO + t * DA + 8 * ln + 4);
                const float mean = wave_sum((x0.x + x0.y) + (x0.z + x0.w) + (x1.x + x1.y) + (x1.z + x1.w), ln) * (1.0f / DA);
                const f32x4 d0 = x0 - mean, d1 = x1 - mean;
                const float var = wave_sum((d0.x * d0.x + d0.y * d0.y) + (d0.z * d0.z + d0.w * d0.w) + (d1.x * d1.x + d1.y * d1.y) + (d1.z * d1.z + d1.w * d1.w), ln) * (1.0f / DA);
                const float rstd = 1.0f / sqrtf(var + EPS);
                f32x4 y0 = d0 * rstd * g0 + b0, y1 = d1 * rstd * g1 + b1;
#pragma unroll
                for (int i = 0; i < 4; ++i) { y0[i] = silu_f(y0[i]); y1[i] = silu_f(y1[i]); }
                *(GAS v4u*)(AB + (size_t)(rowbase + t) * DM + 8 * ln) = (v4u){pk2(y0.x, y0.y), pk2(y0.z, y0.w), pk2(y1.x, y1.y), pk2(y1.z, y1.w)};
            }
            if (lastit) {
                float* o = F.out + OUT_CB_P + ((size_t)(e * NPROMPT + b) * 2) * DA + c;
                o[0] = bf2f(BX[(size_t)(rowbase + 30) * DA + c]); o[DA] = bf2f(BX[(size_t)(rowbase + 31) * DA + c]); }
        }
        __syncthreads();
    }
}

constexpr int VT_PITCH = 272;
template <int NP>
__device__ __forceinline__ void row_stats(const float* st, float& mean, float& rstd) {
    float s1 = 0.f, s2 = 0.f;
#pragma unroll
    for (int p = 0; p < NP; ++p) { s1 += st[2 * p]; s2 += st[2 * p + 1]; }
    mean = s1 * (1.0f / DM); const float var = fmaxf(s2 * (1.0f / DM) - mean * mean, 0.f); rstd = 1.0f / sqrtf(var + EPS);
}
__device__ __forceinline__ int vt_f(int d) { return (d & 15) ^ (d >> 4); }
struct OdPre { v4u va[2], vb[2]; f32x4 ga, gb, ba, bb; f32x4 wsa[4], wsb[4]; v4u uu[4]; float bs; };
__device__ __forceinline__ void odd_item_load(Frame& F, const Args& args, int o, int it, OdPre& P) {
    const bf16* V = (const bf16*)(F.ws + WS_BIG + BIG_V); const bf16* U = (const bf16*)(F.ws + WS_BIG + BIG_U);
    const int ci = it >> 3, h = it & 7, R0 = ci * 128, tl = F.lane & 15, kq = F.lane >> 4, t = 16 * F.wave + tl;
#pragma unroll
    for (int i2 = 0; i2 < 2; ++i2) { const int q = F.tid + 512 * i2, cc = q & 15, rp = q >> 4, col = h * 128 + cc * 8;
        P.va[i2] = *(const GAS v4u*)(V + (size_t)(R0 + 2 * rp) * DM + col); P.vb[i2] = *(const GAS v4u*)(V + (size_t)(R0 + 2 * rp + 1) * DM + col); }
    { const int col = h * 128 + (F.tid & 15) * 8;
        P.ga = *(const f32x4*)(INP(15) + o * DM + col); P.gb = *(const f32x4*)(INP(15) + o * DM + col + 4); P.ba = *(const f32x4*)(INP(16) + o * DM + col); P.bb = *(const f32x4*)(INP(16) + o * DM + col + 4); }
    { const float* wrow = INP(17) + ((size_t)(o * 8 + h) * 128 + t) * 128 + 8 * kq;
#pragma unroll
        for (int kk = 0; kk < 4; ++kk) {
            if (32 * kk <= 16 * F.wave + 15) { P.wsa[kk] = *(const f32x4*)(wrow + 32 * kk); P.wsb[kk] = *(const f32x4*)(wrow + 32 * kk + 4); }
            else { P.wsa[kk] = (f32x4){0.f, 0.f, 0.f, 0.f}; P.wsb[kk] = P.wsa[kk]; } } }
#pragma unroll
    for (int p = 0; p < 4; ++p) P.uu[p] = *(const GAS v4u*)(U + (size_t)(R0 + t) * DM + h * 128 + 32 * p + 8 * kq);
    P.bs = INP(18)[(o * 8 + h) * 128 + t];
}
__device__ __forceinline__ void odd_prep_sample_item(Frame& F, const Args& args, int o, int s) {
    const bf16* U = (const bf16*)(F.ws + WS_BIG + BIG_U); const bf16* V = (const bf16*)(F.ws + WS_BIG + BIG_V); bf16* US = (bf16*)(F.ws + WS_BIG + BIG_US);
    const float* stat = (const float*)(F.ws + WS_STAT);
    LAS float* RS = (LAS float*)(F.lds + RING_OFF);
    const int R0 = MP + s * DSEQ;
    const int col = 2 * F.tid, h = col >> 7;
    const f32x2 g = *(const f32x2*)(INP(15) + o * DM + col), bb = *(const f32x2*)(INP(16) + o * DM + col);
    unsigned vw[DSEQ], uw[DSEQ];
#pragma unroll
    for (int t = 0; t < DSEQ; ++t) { vw[t] = *(const GAS unsigned*)(V + (size_t)(R0 + t) * DM + col); uw[t] = *(const GAS unsigned*)(U + (size_t)(R0 + t) * DM + col); }
    if (F.tid < DSEQ) { float mean, rstd; row_stats<32>(stat + (size_t)MP * 32 + (size_t)(s * DSEQ + F.tid) * 64, mean, rstd); RS[2 * F.tid] = mean; RS[2 * F.tid + 1] = rstd; }
    __syncthreads();
    float vn[DSEQ][2];
#pragma unroll
    for (int t = 0; t < DSEQ; ++t) { const unsigned w = vw[t]; const float m = RS[2 * t], r = RS[2 * t + 1];
        vn[t][0] = (bflo(w) - m) * r * g.x + bb.x; vn[t][1] = (bfhi(w) - m) * r * g.y + bb.y;
        *(f32x2*)(F.out + OUT_CV_S + ((size_t)(o * NSAMP + s) * DSEQ + t) * DM + col) = (f32x2){vn[t][0], vn[t][1]}; }
    const float* ws = INP(17) + (size_t)(o * 8 + h) * 128 * 128; const float* bsp = INP(18) + (o * 8 + h) * 128;
#pragma unroll
    for (int t = 0; t < DSEQ; ++t) { float a0 = bsp[t], a1 = a0;
#pragma unroll
        for (int k = 0; k <= t; ++k) { const float w = ws[t * 128 + k]; a0 = fmaf(w, vn[k][0], a0); a1 = fmaf(w, vn[k][1], a1); }
        const unsigned uu = uw[t];
        *(GAS unsigned*)(US + (size_t)(R0 + t) * DM + col) = pk2(bflo(uu) * a0, bfhi(uu) * a1); }
    __syncthreads();
}
__device__ __forceinline__ void odd_prep_phase(Frame& F, const Args& args, int o) {
    constexpr int NIP = (MP / 128) * 8, NJ = NIP / 256;
    const bf16* U = (const bf16*)(F.ws + WS_BIG + BIG_U); bf16* US = (bf16*)(F.ws + WS_BIG + BIG_US);
    LAS float* RSall = (LAS float*)(F.lds + RING_OFF + 65536);
    const int tl = F.lane & 15, kq = F.lane >> 4, t = 16 * F.wave + tl, c0 = F.bid;
    const int hh = (c0 >> 3) & 7, cbase = 16 * (c0 & 7) + (c0 >> 6);
    OdPre cur;
    {
        const int j = F.tid >> 7, r = F.tid & 127, row = (cbase + 4 * j) * 128 + r;
        const float* st = (const float*)(F.ws + WS_STAT) + (size_t)row * 32; float s1 = 0.f, s2 = 0.f;
#pragma unroll
        for (int i = 0; i < 8; ++i) { const f32x4 v = *(const f32x4*)(st + 4 * i); s1 += v.x + v.z; s2 += v.y + v.w; }
        const float mean = s1 * (1.0f / DM), var = fmaxf(s2 * (1.0f / DM) - mean * mean, 0.f); RSall[2 * F.tid] = mean; RSall[2 * F.tid + 1] = 1.0f / sqrtf(var + EPS);
    }
    __syncthreads();
#pragma unroll 1
    for (int j = 0; j < NJ; ++j) {
        const int ci = cbase + 4 * j, h = hh, it = ci * 8 + h, R0 = ci * 128, b = ci >> 4; const bool last = (ci & 15) == 15;
        odd_item_load(F, args, o, it, cur);
        LAS unsigned char* VT = F.lds + RING_OFF + (j & 1) * 32768;
        const LAS float* RS = RSall + j * 256;
#pragma unroll
        for (int i2 = 0; i2 < 2; ++i2) {
            const int q = F.tid + 512 * i2, cc = q & 15, rp = q >> 4, s0 = 2 * rp, col = h * 128 + cc * 8;
            const float m0 = RS[2 * s0], r0 = RS[2 * s0 + 1], m1 = RS[2 * s0 + 2], r1 = RS[2 * s0 + 3];
            float n0[8], n1[8];
            const float gv[8] = {cur.ga.x, cur.ga.y, cur.ga.z, cur.ga.w, cur.gb.x, cur.gb.y, cur.gb.z, cur.gb.w}, bv[8] = {cur.ba.x, cur.ba.y, cur.ba.z, cur.ba.w, cur.bb.x, cur.bb.y, cur.bb.z, cur.bb.w};
            const unsigned wav[4] = {cur.va[i2].x, cur.va[i2].y, cur.va[i2].z, cur.va[i2].w}, wbv[4] = {cur.vb[i2].x, cur.vb[i2].y, cur.vb[i2].z, cur.vb[i2].w};
#pragma unroll
            for (int i = 0; i < 4; ++i) {
                n0[2 * i] = (bflo(wav[i]) - m0) * r0 * gv[2 * i] + bv[2 * i]; n0[2 * i + 1] = (bfhi(wav[i]) - m0) * r0 * gv[2 * i + 1] + bv[2 * i + 1];
                n1[2 * i] = (bflo(wbv[i]) - m1) * r1 * gv[2 * i] + bv[2 * i]; n1[2 * i + 1] = (bfhi(wbv[i]) - m1) * r1 * gv[2 * i + 1] + bv[2 * i + 1];
            }
            if (last) { float* cv = F.out + OUT_CV_P + ((size_t)(o * NPROMPT + b) * 128 + s0) * DM + col;
                *(f32x4*)cv = (f32x4){n0[0], n0[1], n0[2], n0[3]}; *(f32x4*)(cv + 4) = (f32x4){n0[4], n0[5], n0[6], n0[7]};
                *(f32x4*)(cv + DM) = (f32x4){n1[0], n1[1], n1[2], n1[3]}; *(f32x4*)(cv + DM + 4) = (f32x4){n1[4], n1[5], n1[6], n1[7]}; }
#pragma unroll
            for (int i = 0; i < 8; ++i) { const int d = cc * 8 + i; *(LAS unsigned*)(VT + d * 256 + (((rp >> 2) ^ vt_f(d)) << 4) + ((rp & 3) << 2)) = pk2(n0[i], n1[i]); }
        }
        __syncthreads();
        const float bs = cur.bs;
        f32x4 acc[8];
#pragma unroll
        for (int n = 0; n < 8; ++n) acc[n] = (f32x4){0.f, 0.f, 0.f, 0.f};
#pragma unroll
        for (int kk = 0; kk < 4; ++kk) {
            if (32 * kk <= 16 * F.wave + 15) {
                const int s0 = 32 * kk + 8 * kq;
                float wv[8] = {cur.wsa[kk].x, cur.wsa[kk].y, cur.wsa[kk].z, cur.wsa[kk].w, cur.wsb[kk].x, cur.wsb[kk].y, cur.wsb[kk].z, cur.wsb[kk].w};
#pragma unroll
                for (int jj = 0; jj < 8; ++jj) wv[jj] = (s0 + jj <= t) ? wv[jj] : 0.f;
                v4u wp; wp.x = pk2(wv[0], wv[1]); wp.y = pk2(wv[2], wv[3]); wp.z = pk2(wv[4], wv[5]); wp.w = pk2(wv[6], wv[7]);
                const bf16x8 wf = __builtin_bit_cast(bf16x8, wp);
#pragma unroll
                for (int n = 0; n < 8; ++n) { const int d = 32 * (n >> 1) + 8 * (tl >> 2) + 4 * (n & 1) + (tl & 3);
                    const bf16x8 vf = *(const LAS bf16x8*)(VT + d * 256 + (((4 * kk + kq) ^ vt_f(d)) << 4));
                    acc[n] = __builtin_amdgcn_mfma_f32_16x16x32_bf16(vf, wf, acc[n], 0, 0, 0); }
            }
        }
#pragma unroll
        for (int p = 0; p < 4; ++p) { const size_t off = (size_t)(R0 + t) * DM + h * 128 + 32 * p + 8 * kq; const f32x4 a0 = acc[2 * p], a1 = acc[2 * p + 1]; const v4u w = cur.uu[p];
            *(GAS v4u*)(US + off) = (v4u){pk2(bflo(w.x) * (a0.x + bs), bfhi(w.x) * (a0.y + bs)), pk2(bflo(w.y) * (a0.z + bs), bfhi(w.y) * (a0.w + bs)),
                                          pk2(bflo(w.z) * (a1.x + bs), bfhi(w.z) * (a1.y + bs)), pk2(bflo(w.w) * (a1.z + bs), bfhi(w.w) * (a1.w + bs))}; }
    }
    __syncthreads();
    if (c0 < NSAMP) odd_prep_sample_item(F, args, o, (c0 & 7) * 16 + (c0 >> 3));
}

__global__ void __launch_bounds__(NWAVES * 64, 2) skel_fwd(Args args) {
    extern __shared__ __attribute__((aligned(16))) unsigned char lds[];
    Frame F;
    F.lds = (LAS unsigned char*)lds;
    F.MISC = (volatile LAS unsigned*)(F.lds + MISC_OFF);
    F.tid = threadIdx.x; F.lane = F.tid & 63; F.wave = __builtin_amdgcn_readfirstlane(F.tid >> 6);
    F.G = gridDim.x;
    F.z = 0; F.out = args.out; F.ws = args.ws;
    F.ctl = (gu32*)(args.ws + WS_CTL);
    for (int u = F.tid; u < (LDS_BYTES - LDSCTL_OFF) / 4; u += NWAVES * 64) ((LAS unsigned*)(F.lds + LDSCTL_OFF))[u] = 0u;
    __syncthreads();
    XcdBarrier bar; bar.bar = (unsigned*)(F.ctl + CW_BAR); bar.x = 0; bar.st = nullptr;
#if MK_ONE_LAUNCH
    bar = xcd_barrier_post((unsigned*)(F.ctl + CW_BAR), F.MISC + 8);
#endif
    const int lo = args.ph_lo, hi = args.ph_hi;
    bool repeated = false;
#pragma unroll 1
    for (int p = lo; p < hi; ++p) {
        { int z = 0; asm volatile("" : "+s"(z)); F.z = z; F.out = args.out + z; F.ws = args.ws + z;
          int t_ = threadIdx.x; asm volatile("" : "+v"(t_)); F.tid = t_; F.lane = t_ & 63; F.wave = __builtin_amdgcn_readfirstlane(t_ >> 6);
          int b_ = blockIdx.x; asm volatile("" : "+s"(b_)); F.bid = b_; }
        float* const X = F.out + OUT_Y;
        int kind = -1;
        pg8::Gemm g{nullptr, nullptr, nullptr, 0, 0, 0}; pg8::EpiAny E{0, false, 0, nullptr, nullptr, nullptr, nullptr, nullptr, nullptr, nullptr, nullptr, nullptr};
        bf16* const H = (bf16*)(F.ws + WS_H);
        if (p == 0) { p0_prologue(F, args); }
        else if (p == 1) {
            kind = 0; g = pg8::Gemm{(const bf16*)(F.ws + WS_CACT), (const bf16*)(F.ws + WS_WADA), (const bf16*)(F.ws + WS_CACT), 256, NMOD, DM};
            E.kind = 0; E.perm = false; E.ldc = NMOD; E.p0 = (void*)(F.ws + WS_MOD); E.f0 = INP(21);
        } else if (p == 2) {
            norm_phase(F, args, INP(0), INP(1), INP(22), (const float*)(F.ws + WS_MOD) + 0 * DM, (const float*)(F.ws + WS_MOD) + 1 * DM, H);
        } else {
            const int l = (p - 3) / 5, k = (p - 3) % 5, eo = l >> 1; const bool even = (l & 1) == 0;
            bf16* const XB = (bf16*)(F.ws + WS_XB);
            const float* xp = l == 0 ? INP(0) : (const float*)XB; const float* xs = l == 0 ? INP(1) : (const float*)(XB + (size_t)MP * DM);
            const float* modl = (const float*)(F.ws + WS_MOD) + (size_t)l * NMODL;
            if (k == 1) {
                if (even) {
                    kind = 5; g = pg8::Gemm{H, (const bf16*)(F.ws + WS_WINAB) + (size_t)eo * DIN_E * DM + (size_t)2048 * DM, H + (size_t)MP * DM, MP, 512, DM};
                    E.kind = 5; E.perm = true; E.p0 = (void*)(F.ws + WS_BIG + BIG_AB); E.p1 = (void*)(F.ws + WS_BIG + BIG_BX); E.f0 = INP(11) + (size_t)eo * 3 * DA; E.f1 = INP(3) + (size_t)eo * NSAMP * 2 * DA;
                } else odd_prep_phase(F, args, eo);
            }
            else if (k == 0) {
                if (even) { kind = 1; g = pg8::Gemm{H, (const bf16*)(F.ws + WS_WINAB) + (size_t)eo * DIN_E * DM, H + (size_t)MP * DM, MP, 2048, DM};
                    E.kind = 1; E.perm = true; E.p0 = (void*)(F.ws + WS_BIG + BIG_AG); E.p1 = (void*)(F.ws + WS_BIG + BIG_BX); E.p2 = (void*)(F.ws + WS_BIG + BIG_BB); }
                else { kind = 2; g = pg8::Gemm{H, (const bf16*)(F.ws + WS_WINC) + (size_t)eo * 2048 * DM, H + (size_t)MP * DM, MP, 2048, DM};
                    E.kind = 2; E.perm = true; E.p0 = (void*)(F.ws + WS_BIG + BIG_U); E.p1 = (void*)(F.ws + WS_BIG + BIG_V); E.f0 = INP(14) + (size_t)eo * 2048; E.f3 = (float*)(F.ws + WS_STAT); }
            } else if (k == 3) {
                kind = 4; g = pg8::Gemm{H, (const bf16*)(F.ws + WS_WFF1) + (size_t)l * DFF * DM, H + (size_t)MP * DM, MP, DFF, DM};
                E.kind = 4; E.perm = true; E.ldc = DFF; E.p0 = (void*)(F.ws + WS_BIG);
            } else {
                kind = 3; const int seam = 2 * l + (k == 4);
                if (k == 2) { const bf16* Amix = even ? (const bf16*)(F.ws + WS_BIG + BIG_AB) : (const bf16*)(F.ws + WS_BIG + BIG_US);
                    g = pg8::Gemm{Amix, (even ? (const bf16*)(F.ws + WS_WOUTAB) : (const bf16*)(F.ws + WS_WOUTC)) + (size_t)eo * DM * DM, Amix + (size_t)MP * DM, MP, DM, DM};
                    E.f0 = INP(22) + (size_t)seam * DM; E.f1 = modl; E.ldc = 0;
                    E.f2 = modl + 2 * DM; E.f4 = INP(22) + (size_t)(l * 2 + 1) * DM; E.f5 = modl + 3 * DM; }
                else { g = pg8::Gemm{(const bf16*)(F.ws + WS_BIG), (const bf16*)(F.ws + WS_WFF2) + (size_t)l * DM * DFF, (const bf16*)(F.ws + WS_BIG) + (size_t)MP * DFF, MP, DM, DFF};
                    E.f0 = INP(22) + (size_t)seam * DM; E.f1 = modl + 3 * DM; E.f2 = modl + 5 * DM;
                    if (l == 3) { E.ldc = 1; E.f4 = INP(25); E.f5 = modl; } else { E.f4 = INP(22) + (size_t)((l + 1) * 2 + 0) * DM; E.f5 = modl + NMODL; } }
                E.kind = 3; E.perm = true; E.f3 = X; E.p0 = (void*)H; E.ldc |= seam << 8;
                E.p1 = (void*)(F.ws + WS_XBUF); E.p2 = (void*)((unsigned*)(F.ws + WS_CTL) + CW_SEAM + seam * 64 * 64);
            }
        }
        if (kind >= 0) {
            pg8::StaticOrder S; S.init(g.M, g.N, F.G, F.bid);
            pg8::gemm_phase<pg8::EpiAny, pg8::StaticOrder, PG8_ALIGN, PG8_SP2>(F.lds + RING_OFF, g, S, E);
            if (kind == 0 && F.bid >= 96) {
                int t_ = threadIdx.x; asm volatile("" : "+v"(t_)); F.tid = t_; F.lane = t_ & 63; F.wave = __builtin_amdgcn_readfirstlane(t_ >> 6);
                p0_items<true>(F, args, (F.bid - 96) * NWAVES + F.wave, (F.G - 96) * NWAVES); }
            if (kind == 5) {
                int t_ = threadIdx.x; asm volatile("" : "+v"(t_)); F.tid = t_; F.lane = t_ & 63; F.wave = __builtin_amdgcn_readfirstlane(t_ >> 6);
                even_prep_light(F, args, ((p - 3) / 5) >> 1); }
        }
        if (p + 1 < hi) xcd_barrier(bar);
        if (REP_P >= 0 && p == REP_P && !repeated) { repeated = true; --p; }
    }
}

extern "C" void kernel_launch(void* const* d_in, const int* in_sizes, int n_in, void* d_out, int out_size, void* d_ws, size_t ws_size, hipStream_t stream) {
    static int grid = 0;
    if (grid == 0) {
        if (n_in != 26 || out_size != (int)OUT_END || ws_size < WS_END) { fprintf(stderr, "kernel_launch: unexpected shapes: n_in %d out %d ws %zu\n", n_in, out_size, ws_size); grid = -1; return; }
        int dev = 0, cus = 0, per_cu = 0;
        if (hipGetDevice(&dev) != hipSuccess || hipDeviceGetAttribute(&cus, hipDeviceAttributeMultiprocessorCount, dev) != hipSuccess) { grid = -1; return; }
        if (hipFuncSetAttribute((const void*)skel_fwd, hipFuncAttributeMaxDynamicSharedMemorySize, LDS_BYTES) != hipSuccess) { fprintf(stderr, "kernel_launch: hipFuncSetAttribute failed\n"); grid = -1; return; }
        if (hipOccupancyMaxActiveBlocksPerMultiprocessor(&per_cu, (const void*)skel_fwd, NWAVES * 64, LDS_BYTES) != hipSuccess || per_cu < 1) { fprintf(stderr, "kernel_launch: occupancy query says %d workgroups per CU\n", per_cu); (void)hipGetLastError(); grid = -1; return; }
        if (cus != 256) { fprintf(stderr, "kernel_launch: built for a 256-CU device (the fused norm epilogues need one 272x256 unit per workgroup); this device has %d CUs\n", cus); grid = -1; return; }
        grid = cus;
    }
    if (grid < 0) return;
    (void)hipMemsetAsync((char*)d_ws + WS_CTL, 0, CTL_ZERO_BYTES, stream);
    Args a{};
    for (int i = 0; i < 26; ++i) a.in[i] = (const float*)d_in[i];
    a.out = (float*)d_out; a.ws = (unsigned char*)d_ws;
#if MK_ONE_LAUNCH
    a.ph_lo = 0; a.ph_hi = N_PHASES; a.li = 0;
    hipLaunchKernelGGL(skel_fwd, dim3(grid), dim3(NWAVES * 64), LDS_BYTES, stream, a);
#else
    for (int p = 0; p < N_PHASES; ++p) { a.ph_lo = p; a.ph_hi = p + 1; a.li = p; hipLaunchKernelGGL(skel_fwd, dim3(grid), dim3(NWAVES * 64), LDS_BYTES, stream, a); }
#endif
}
```

```cpp
#include <hip/hip_runtime.h>
#include <cstdio>
#include <cstdint>

#ifndef PH_MASK
#define PH_MASK 0xFFFF
#endif
#define PH_ON(b) ((PH_MASK >> (b)) & 1)
#ifndef REP_P
#define REP_P -1
#endif
#ifndef MK_ONE_LAUNCH
#define MK_ONE_LAUNCH 1
#endif

constexpr int DM = 1024, NPROMPT = 8, SEQ = 2048, NSAMP = 128, DSEQ = 8;
constexpr int MP = NPROMPT * SEQ;
constexpr int MS = NSAMP * DSEQ;
constexpr int MT = MP + MS;
constexpr int NSEQ = NPROMPT + NSAMP;
constexpr int DA = 512, DIN_E = 2560, DFF = 4096, NMODL = 6 * DM, NMOD = 4 * NMODL;
constexpr float EPS = 1e-6f;

__device__ __forceinline__ float shfl_xor_l(float v, int mask, int lane) { return __builtin_bit_cast(float, __builtin_amdgcn_ds_bpermute((lane ^ mask) << 2, __builtin_bit_cast(int, v))); }
__device__ __forceinline__ int seq_of_row(int row) { return row < MP ? (row >> 11) : NPROMPT + ((row - MP) >> 3); }

namespace pg8 {
#define PG8_LAS __attribute__((address_space(3)))
typedef unsigned short bf16_t;
typedef short bf16x8 __attribute__((ext_vector_type(8)));
typedef float f32x4 __attribute__((ext_vector_type(4)));
typedef unsigned u32x4 __attribute__((ext_vector_type(4)));
constexpr int BM = 256, BK = 64, HALF = 128, HTB = HALF * BK * 2  , STAGE_BYTES = 8 * HTB, NXCD = 8, WGM = 8;

__host__ __device__ __forceinline__ int lds_byte(int r, int c) { const int st = (r >> 4) * 2 + (c >> 5), rr = r & 15, cc = c & 31, ob = rr * 64 + cc * 2; return st * 1024 + (ob ^ (((ob >> 9) & 1) << 5)); }
__host__ __device__ __forceinline__ void stage_rc(int b, int& R, int& C) { const int st = b / 1024, sb = b % 1024, swz = sb ^ (((sb >> 9) & 1) << 5); R = (st >> 1) * 16 + swz / 64; C = (st & 1) * 32 + (swz % 64) / 2; }
__host__ __device__ __forceinline__ int perm32(int rho) { const int n = rho >> 4, i = rho & 15; return 8 * (i >> 2) + 4 * n + (i & 3); }

struct Unit { int pm, pn; };
struct Gemm { const bf16_t* A; const bf16_t* Bt; const bf16_t* AX; int M, N, K; };

struct StaticOrder {
    int nM, nN, nwg, G, c;
    __host__ __device__ void init(int M, int N, int G_, int c_) { nM = M / BM; nN = N / BM; nwg = nM * nN; G = G_; c = c_; }
    __host__ __device__ bool next(int i, Unit& u) const {
        const long L = (long)i * G + c; if (L >= nwg) return false;
        int wgid = (int)L; { const int q = nwg / NXCD, r = nwg % NXCD, xcd = wgid % NXCD, off = wgid / NXCD; wgid = (xcd < r ? xcd * (q + 1) : r * (q + 1) + (xcd - r) * q) + off; }
        const int nig = WGM * nN, gid = wgid / nig, fm = gid * WGM, gsz = (nM - fm) < WGM ? (nM - fm) : WGM;
        u.pm = fm + ((wgid % nig) % gsz); u.pn = (wgid % nig) / gsz; return true;
    }
    __device__ __forceinline__ void a_ready(const Unit&) const {}
    __device__ __forceinline__ void done(const Unit&) const {}
};

typedef float cvt_f32x2_ __attribute__((ext_vector_type(2)));
typedef __bf16 cvt_bf16x2_ __attribute__((ext_vector_type(2)));
__device__ __forceinline__ unsigned cvt_pk_bf16(float lo, float hi) { const cvt_f32x2_ v = {lo, hi}; return __builtin_bit_cast(unsigned, __builtin_convertvector(v, cvt_bf16x2_)); }
__device__ __forceinline__ float sigmoid_f(float x) { return __builtin_amdgcn_rcpf(1.0f + __expf(-x)); }
__device__ __forceinline__ float gelu_tanh_f(float x) { const float y = 1.5957691216057308f * (x + 0.044715f * x * x * x); return x * sigmoid_f(y); }

struct EpiF32 {
    static constexpr bool PERM = false, AFTER_DRAIN = false;
    float* C; int ldc; const float* bias;
    __device__ __forceinline__ void operator()(const f32x4 (&acc)[2][2][4][2], const f32x4 (&accx)[2], const Unit& u, int wr, int wc, int fr, int fq) const {
        const int row0 = u.pm * BM + wr * 64 + fr, col0 = u.pn * BM + wc * 32 + 4 * fq;
        f32x4 bv[2][2];
#pragma unroll
        for (int bj = 0; bj < 2; ++bj)
#pragma unroll
            for (int n = 0; n < 2; ++n) bv[bj][n] = *(const f32x4*)(bias + col0 + bj * HALF + n * 16);
#pragma unroll
        for (int ai = 0; ai < 2; ++ai)
#pragma unroll
            for (int m = 0; m < 4; ++m) { float* rowp = C + (size_t)(row0 + ai * HALF + m * 16) * ldc + col0;
#pragma unroll
                for (int bj = 0; bj < 2; ++bj)
#pragma unroll
                    for (int n = 0; n < 2; ++n) *(f32x4*)(rowp + bj * HALF + n * 16) = acc[ai][bj][m][n] + bv[bj][n]; }
    }
};
struct EpiResid {
    static constexpr bool PERM = false, AFTER_DRAIN = false;
    const float* xp; const float* xs; float* out; const float* gate;
    __device__ __forceinline__ void operator()(const f32x4 (&acc)[2][2][4][2], const f32x4 (&accx)[2], const Unit& u, int wr, int wc, int fr, int fq) const {
        const int row0 = u.pm * BM + wr * 64 + fr, col0 = u.pn * BM + wc * 32 + 4 * fq;
        {
            const int srow = 16 * u.pm + fr, colx = u.pn * BM + wc * 32 + 16 * wr + 4 * fq;
            const float* src = xs + (size_t)srow * DM + colx; const float* g = gate + (size_t)(NPROMPT + (srow >> 3)) * NMOD + colx; float* dst = out + (size_t)(MP + srow) * DM + colx;
#pragma unroll
            for (int bj = 0; bj < 2; ++bj) { const f32x4 b = *(const f32x4*)(src + bj * HALF), gv = *(const f32x4*)(g + bj * HALF); *(f32x4*)(dst + bj * HALF) = b + gv * accx[bj]; }
        }
#pragma unroll
        for (int ai = 0; ai < 2; ++ai)
#pragma unroll
            for (int m = 0; m < 4; ++m) {
                const int row = row0 + ai * HALF + m * 16;
                const float* src = (row < MP ? xp + (size_t)row * DM : xs + (size_t)(row - MP) * DM) + col0;
                const float* g = gate + (size_t)seq_of_row(row) * NMOD + col0;
                float* dst = out + (size_t)row * DM + col0;
#pragma unroll
                for (int bj = 0; bj < 2; ++bj)
#pragma unroll
                    for (int n = 0; n < 2; ++n) { const f32x4 b = *(const f32x4*)(src + bj * HALF + n * 16), gv = *(const f32x4*)(g + bj * HALF + n * 16);
                        *(f32x4*)(dst + bj * HALF + n * 16) = b + gv * acc[ai][bj][m][n]; }
            }
    }
};
struct EpiRelu2 {
    static constexpr bool PERM = true, AFTER_DRAIN = false;
    bf16_t* O; int ldc;
    __device__ __forceinline__ void operator()(const f32x4 (&acc)[2][2][4][2], const f32x4 (&accx)[2], const Unit& u, int wr, int wc, int fr, int fq) const {
        const int row0 = u.pm * BM + wr * 64 + fr, col0 = u.pn * BM + wc * 32 + 8 * fq;
        {
            bf16_t* rowp = O + (size_t)(MP + 16 * u.pm + fr) * ldc + col0 + 4 * wr;
#pragma unroll
            for (int bj = 0; bj < 2; ++bj) { f32x4 v = __builtin_elementwise_max(accx[bj], (f32x4){0.f, 0.f, 0.f, 0.f}); v = v * v;
                typedef unsigned u32x2v __attribute__((ext_vector_type(2))); *(u32x2v*)(rowp + bj * HALF) = (u32x2v){cvt_pk_bf16(v[0], v[1]), cvt_pk_bf16(v[2], v[3])}; }
        }
#pragma unroll
        for (int ai = 0; ai < 2; ++ai)
#pragma unroll
            for (int m = 0; m < 4; ++m) { bf16_t* rowp = O + (size_t)(row0 + ai * HALF + m * 16) * ldc + col0;
#pragma unroll
                for (int bj = 0; bj < 2; ++bj) { f32x4 v0 = acc[ai][bj][m][0], v1 = acc[ai][bj][m][1];
                    v0 = __builtin_elementwise_max(v0, (f32x4){0.f, 0.f, 0.f, 0.f}); v1 = __builtin_elementwise_max(v1, (f32x4){0.f, 0.f, 0.f, 0.f}); v0 = v0 * v0; v1 = v1 * v1;
                    u32x4 w; w.x = cvt_pk_bf16(v0[0], v0[1]); w.y = cvt_pk_bf16(v0[2], v0[3]); w.z = cvt_pk_bf16(v1[0], v1[1]); w.w = cvt_pk_bf16(v1[2], v1[3]);
                    *(u32x4*)(rowp + bj * HALF) = w; } }
    }
};
struct EpiEvenIn {
    static constexpr bool PERM = true, AFTER_DRAIN = false;
    bf16_t *AG, *BX, *BB;
    __device__ __forceinline__ void operator()(const f32x4 (&acc)[2][2][4][2], const f32x4 (&accx)[2], const Unit& u, int wr, int wc, int fr, int fq) const {
        const int row0 = u.pm * BM + wr * 64 + fr, cw = wc * 32 + 8 * fq;
        {
            typedef unsigned u32x2v __attribute__((ext_vector_type(2)));
            const size_t xrow = (size_t)(MP + 16 * u.pm + fr) * DA; const int cx = cw + 4 * wr;
            if (u.pn < 8) { f32x4 r;
                if (u.pn < 4) {
#pragma unroll
                    for (int i = 0; i < 4; ++i) r[i] = accx[0][i] * sigmoid_f(accx[1][i]);
                } else r = accx[0] * accx[1];
                *(u32x2v*)((u.pn < 4 ? AG : BX) + xrow + 128 * (u.pn & 3) + cx) = (u32x2v){cvt_pk_bf16(r[0], r[1]), cvt_pk_bf16(r[2], r[3])};
            } else {
#pragma unroll
                for (int bj = 0; bj < 2; ++bj) *(u32x2v*)(BB + xrow + 256 * (u.pn - 8) + bj * HALF + cx) = (u32x2v){cvt_pk_bf16(accx[bj][0], accx[bj][1]), cvt_pk_bf16(accx[bj][2], accx[bj][3])};
            }
        }
        if (u.pn < 8) {
            bf16_t* O = (u.pn < 4 ? AG : BX) + 128 * (u.pn & 3) + cw; const bool glu = u.pn < 4;
#pragma unroll
            for (int ai = 0; ai < 2; ++ai)
#pragma unroll
                for (int m = 0; m < 4; ++m) { bf16_t* rowp = O + (size_t)(row0 + ai * HALF + m * 16) * DA;
                    const f32x4 a0 = acc[ai][0][m][0], a1 = acc[ai][0][m][1], g0 = acc[ai][1][m][0], g1 = acc[ai][1][m][1]; f32x4 r0, r1;
                    if (glu) {
#pragma unroll
                        for (int i = 0; i < 4; ++i) { r0[i] = a0[i] * sigmoid_f(g0[i]); r1[i] = a1[i] * sigmoid_f(g1[i]); }
                    } else { r0 = a0 * g0; r1 = a1 * g1; }
                    u32x4 w; w.x = cvt_pk_bf16(r0[0], r0[1]); w.y = cvt_pk_bf16(r0[2], r0[3]); w.z = cvt_pk_bf16(r1[0], r1[1]); w.w = cvt_pk_bf16(r1[2], r1[3]);
                    *(u32x4*)rowp = w; }
        } else {
            bf16_t* O = BB + 256 * (u.pn - 8) + cw;
#pragma unroll
            for (int ai = 0; ai < 2; ++ai)
#pragma unroll
                for (int m = 0; m < 4; ++m) { bf16_t* rowp = O + (size_t)(row0 + ai * HALF + m * 16) * DA;
#pragma unroll
                    for (int bj = 0; bj < 2; ++bj) { const f32x4 v0 = acc[ai][bj][m][0], v1 = acc[ai][bj][m][1];
                        u32x4 w; w.x = cvt_pk_bf16(v0[0], v0[1]); w.y = cvt_pk_bf16(v0[2], v0[3]); w.z = cvt_pk_bf16(v1[0], v1[1]); w.w = cvt_pk_bf16(v1[2], v1[3]);
                        *(u32x4*)(rowp + bj * HALF) = w; } }
        }
    }
};
struct EpiOddIn {
    static constexpr bool PERM = true, AFTER_DRAIN = false;
    bf16_t *U, *V; const float* bias; float* stat;
    __device__ __forceinline__ void operator()(const f32x4 (&acc)[2][2][4][2], const f32x4 (&accx)[2], const Unit& u, int wr, int wc, int fr, int fq) const {
        const int row0 = u.pm * BM + wr * 64 + fr, cw = wc * 32 + 8 * fq, bcol0 = u.pn * BM + cw;
        const bool isv = u.pn >= 4;
        bf16_t* O = (isv ? V + 256 * (u.pn - 4) : U + 256 * u.pn) + cw;
        f32x4 bv[2][2];
#pragma unroll
        for (int bj = 0; bj < 2; ++bj)
#pragma unroll
            for (int n = 0; n < 2; ++n) bv[bj][n] = *(const f32x4*)(bias + bcol0 + bj * HALF + 4 * n);
        {
            typedef unsigned u32x2v __attribute__((ext_vector_type(2))); typedef float f32x2v __attribute__((ext_vector_type(2)));
            const int srow = 16 * u.pm + fr; bf16_t* rowp = O + (size_t)(MP + srow) * DM + 4 * wr; float s1 = 0.f, s2 = 0.f;
            const f32x4 bsl[2] = {*(const f32x4*)(bias + bcol0 + 4 * wr), *(const f32x4*)(bias + bcol0 + HALF + 4 * wr)};
#pragma unroll
            for (int bj = 0; bj < 2; ++bj) { f32x4 v = accx[bj] + bsl[bj];
#pragma unroll
                for (int i = 0; i < 4; ++i) v[i] = gelu_tanh_f(v[i]);
                s1 += (v[0] + v[1]) + (v[2] + v[3]); s2 += (v[0] * v[0] + v[1] * v[1]) + (v[2] * v[2] + v[3] * v[3]);
                *(u32x2v*)(rowp + bj * HALF) = (u32x2v){cvt_pk_bf16(v[0], v[1]), cvt_pk_bf16(v[2], v[3])}; }
            if (isv) { s1 += __shfl_xor(s1, 16); s1 += __shfl_xor(s1, 32); s2 += __shfl_xor(s2, 16); s2 += __shfl_xor(s2, 32);
                if (fq == 0) *(f32x2v*)(stat + (size_t)MP * 32 + ((size_t)srow * 32 + (u.pn - 4) * 8 + wr * 4 + wc) * 2) = (f32x2v){s1, s2}; }
        }
#pragma unroll
        for (int ai = 0; ai < 2; ++ai)
#pragma unroll
            for (int m = 0; m < 4; ++m) { const int row = row0 + ai * HALF + m * 16; bf16_t* rowp = O + (size_t)row * DM; float s1 = 0.f, s2 = 0.f;
#pragma unroll
                for (int bj = 0; bj < 2; ++bj) { f32x4 v0 = acc[ai][bj][m][0] + bv[bj][0], v1 = acc[ai][bj][m][1] + bv[bj][1];
#pragma unroll
                    for (int i = 0; i < 4; ++i) { v0[i] = gelu_tanh_f(v0[i]); v1[i] = gelu_tanh_f(v1[i]); }
                    s1 += (v0[0] + v0[1]) + (v0[2] + v0[3]) + (v1[0] + v1[1]) + (v1[2] + v1[3]);
                    s2 += (v0[0] * v0[0] + v0[1] * v0[1]) + (v0[2] * v0[2] + v0[3] * v0[3]) + (v1[0] * v1[0] + v1[1] * v1[1]) + (v1[2] * v1[2] + v1[3] * v1[3]);
                    u32x4 w; w.x = cvt_pk_bf16(v0[0], v0[1]); w.y = cvt_pk_bf16(v0[2], v0[3]); w.z = cvt_pk_bf16(v1[0], v1[1]); w.w = cvt_pk_bf16(v1[2], v1[3]);
                    *(u32x4*)(rowp + bj * HALF) = w; }
                if (isv) { s1 += __shfl_xor(s1, 16); s1 += __shfl_xor(s1, 32); s2 += __shfl_xor(s2, 16); s2 += __shfl_xor(s2, 32);
                    if (fq == 0) { typedef float f32x2v __attribute__((ext_vector_type(2))); *(f32x2v*)(stat + ((size_t)row * 16 + (u.pn - 4) * 4 + wc) * 2) = (f32x2v){s1, s2}; } }
            }
    }
};

struct EpiBBconv {
    static constexpr bool PERM = true;
    const bf16_t* BX; bf16_t* AB; const float* cw; const float* hist;
    __device__ __forceinline__ static f32x4 bf4(unsigned a, unsigned b) { return (f32x4){__builtin_bit_cast(float, a << 16), __builtin_bit_cast(float, a & 0xffff0000u), __builtin_bit_cast(float, b << 16), __builtin_bit_cast(float, b & 0xffff0000u)}; }
    __device__ __forceinline__ void operator()(const f32x4 (&acc)[2][2][4][2], const f32x4 (&accx)[2], const Unit& u, int wr, int wc, int fr_in, int fq) const {
        typedef unsigned u32x2v __attribute__((ext_vector_type(2)));
        const int cwv = u.pn * BM + wc * 32 + 8 * fq;
        {   const int fr = fr_in;
            const int srow = 16 * u.pm + fr, t = srow & 7, sq = srow >> 3;
#pragma unroll
            for (int bj = 0; bj < 2; ++bj) { const int c = cwv + bj * HALF + 4 * wr;
                const f32x4 w0 = *(const f32x4*)(cw + c), w1 = *(const f32x4*)(cw + DA + c), w2 = *(const f32x4*)(cw + 2 * DA + c);
                const u32x2v x2 = *(const u32x2v*)(BX + (size_t)(MP + srow) * DA + c), x1 = *(const u32x2v*)(BX + (size_t)(MP + srow - (t >= 1 ? 1 : 0)) * DA + c), x0 = *(const u32x2v*)(BX + (size_t)(MP + srow - (t >= 2 ? 2 : 0)) * DA + c);
                const f32x4 h1 = *(const f32x4*)(hist + ((size_t)sq * 2 + 1) * DA + c), h0 = *(const f32x4*)(hist + ((size_t)sq * 2 + (t >= 1 ? 1 : 0)) * DA + c);
                const f32x4 b2 = bf4(x2.x, x2.y), b1 = t >= 1 ? bf4(x1.x, x1.y) : h1, b0 = t >= 2 ? bf4(x0.x, x0.y) : h0;
                const f32x4 o = accx[bj] * (w0 * b0 + w1 * b1 + w2 * b2);
                *(u32x2v*)(AB + (size_t)(MP + srow) * DM + DA + c) = (u32x2v){cvt_pk_bf16(o[0], o[1]), cvt_pk_bf16(o[2], o[3])}; }
        }
#pragma unroll
        for (int bj = 0; bj < 2; ++bj) { const int c = cwv + bj * HALF;
            f32x4 w[3][2];
#pragma unroll
            for (int k = 0; k < 3; ++k) { w[k][0] = *(const f32x4*)(cw + k * DA + c); w[k][1] = *(const f32x4*)(cw + k * DA + c + 4); }
#pragma unroll
            for (int am = 0; am < 4; ++am) { const int ai = am >> 1, mb = (am & 1) * 2;
                int fr = fr_in; asm volatile("" : "+v"(fr));
                u32x4 xr[2][3];
#pragma unroll
                for (int mm = 0; mm < 2; ++mm) { const int row = u.pm * BM + ai * HALF + wr * 64 + (mb + mm) * 16 + fr, t = row & (SEQ - 1);
#pragma unroll
                    for (int d = 0; d < 3; ++d) xr[mm][d] = *(const u32x4*)(BX + (size_t)(row - (t >= d ? d : 0)) * DA + c); }
#pragma unroll
                for (int mm = 0; mm < 2; ++mm) { const int m = mb + mm, row = u.pm * BM + ai * HALF + wr * 64 + m * 16 + fr, t = row & (SEQ - 1);
                    const f32x4 z = (f32x4){0.f, 0.f, 0.f, 0.f};
                    const f32x4 b2l = bf4(xr[mm][0].x, xr[mm][0].y), b2h = bf4(xr[mm][0].z, xr[mm][0].w);
                    const f32x4 b1l = t >= 1 ? bf4(xr[mm][1].x, xr[mm][1].y) : z, b1h = t >= 1 ? bf4(xr[mm][1].z, xr[mm][1].w) : z;
                    const f32x4 b0l = t >= 2 ? bf4(xr[mm][2].x, xr[mm][2].y) : z, b0h = t >= 2 ? bf4(xr[mm][2].z, xr[mm][2].w) : z;
                    const f32x4 ol = acc[ai][bj][m][0] * (w[0][0] * b0l + w[1][0] * b1l + w[2][0] * b2l), oh = acc[ai][bj][m][1] * (w[0][1] * b0h + w[1][1] * b1h + w[2][1] * b2h);
                    *(u32x4*)(AB + (size_t)row * DM + DA + c) = (u32x4){cvt_pk_bf16(ol[0], ol[1]), cvt_pk_bf16(ol[2], ol[3]), cvt_pk_bf16(oh[0], oh[1]), cvt_pk_bf16(oh[2], oh[3])}; }
                asm volatile("" ::: "memory"); }
        }
    }
};
struct EpiResidNorm {
    static constexpr bool PERM = true;
    const void* xp; const void* xs; void* out; const float* gate;
    bf16_t* H; const float* ng; const float* msh; float* xbuf; unsigned* cnt; bool fin, xf32; float* rn; unsigned epoch;
    typedef unsigned u32x2v_ __attribute__((ext_vector_type(2)));
    __device__ __forceinline__ static float inv_scale(float d) { return __builtin_amdgcn_rcpf(__builtin_copysignf(__builtin_fmaxf(__builtin_fabsf(d), 0x1p-12f), d)); }
    __device__ __forceinline__ static f32x4 bf4(unsigned a, unsigned b) { return (f32x4){__builtin_bit_cast(float, a << 16), __builtin_bit_cast(float, a & 0xffff0000u), __builtin_bit_cast(float, b << 16), __builtin_bit_cast(float, b & 0xffff0000u)}; }
    __device__ __forceinline__ void ld8(const void* base, size_t off, f32x4& lo, f32x4& hi) const {
        if (xf32) { lo = *(const f32x4*)((const float*)base + off); hi = *(const f32x4*)((const float*)base + off + 4); }
        else { const u32x4 w = *(const u32x4*)((const bf16_t*)base + off); lo = bf4(w.x, w.y); hi = bf4(w.z, w.w); }
    }
    __device__ __forceinline__ f32x4 ld4(const void* base, size_t off) const {
        if (xf32) return *(const f32x4*)((const float*)base + off);
        const u32x2v_ w = *(const u32x2v_*)((const bf16_t*)base + off); return bf4(w.x, w.y);
    }
    __device__ __forceinline__ void fused(f32x4 (&acc)[2][2][4][2], f32x4 (&accx)[2], const Unit& u, int wr, int wc, int fr, int fq, PG8_LAS unsigned char* lds, int wid, int lane) const {
        PG8_LAS float* P = (PG8_LAS float*)lds;
        PG8_LAS float* PX = (PG8_LAS float*)(lds + 4096);
        PG8_LAS float* S = (PG8_LAS float*)(lds + 4096 + 512);
        const int col0 = u.pn * BM + wc * 32 + 8 * fq, colx = col0 + 4 * wr, tid = wid * 64 + lane;
        f32x4 gvm[2][2];
#pragma unroll
        for (int bj = 0; bj < 2; ++bj)
#pragma unroll
            for (int n = 0; n < 2; ++n) gvm[bj][n] = *(const f32x4*)(gate + (size_t)(u.pm >> 3) * NMOD + col0 + bj * HALF + n * 4);
#pragma unroll
        for (int ai = 0; ai < 2; ++ai)
#pragma unroll
            for (int bj = 0; bj < 2; ++bj)
#pragma unroll
                for (int m = 0; m < 4; ++m) { acc[ai][bj][m][0] = acc[ai][bj][m][0] * gvm[bj][0]; acc[ai][bj][m][1] = acc[ai][bj][m][1] * gvm[bj][1]; }
        asm volatile("" ::: "memory");
        f32x4 ivp[2][2], shp[2][2];
        { const float* shr = (const float*)xs + (size_t)(u.pm >> 3) * NMOD + col0;
#pragma unroll
            for (int bj = 0; bj < 2; ++bj)
#pragma unroll
                for (int n = 0; n < 2; ++n) { const int c = bj * HALF + n * 4; const f32x4 gp = *(const f32x4*)((const float*)xp + col0 + c), sc = *(const f32x4*)(shr + DM + c); shp[bj][n] = *(const f32x4*)(shr + c);
                    const f32x4 d = gp * (sc + 1.0f); ivp[bj][n] = (f32x4){inv_scale(d[0]), inv_scale(d[1]), inv_scale(d[2]), inv_scale(d[3])}; } }
#pragma unroll
        for (int am = 0; am < 4; ++am) { const int ai = am >> 1, mb = (am & 1) * 2;
            int frb = fr; asm volatile("" : "+v"(frb));
            u32x4 xr[2][2]; float rnp[2];
#pragma unroll
            for (int mm = 0; mm < 2; ++mm) { const int row = u.pm * BM + ai * HALF + wr * 64 + (mb + mm) * 16 + frb; rnp[mm] = rn[row];
#pragma unroll
                for (int bj = 0; bj < 2; ++bj) xr[mm][bj] = *(const u32x4*)(H + (size_t)row * DM + col0 + bj * HALF); }
#pragma unroll
            for (int mm = 0; mm < 2; ++mm) { const int m = mb + mm, r = ai * HALF + wr * 64 + m * 16 + frb; float ss = 0.f;
#pragma unroll
                for (int bj = 0; bj < 2; ++bj) {
                    const f32x4 b0 = (bf4(xr[mm][bj].x, xr[mm][bj].y) - shp[bj][0]) * ivp[bj][0] * rnp[mm], b1 = (bf4(xr[mm][bj].z, xr[mm][bj].w) - shp[bj][1]) * ivp[bj][1] * rnp[mm];
                    const f32x4 x0 = b0 + acc[ai][bj][m][0], x1 = b1 + acc[ai][bj][m][1]; acc[ai][bj][m][0] = x0; acc[ai][bj][m][1] = x1;
                    ss += (x0[0] * x0[0] + x0[1] * x0[1]) + (x0[2] * x0[2] + x0[3] * x0[3]) + (x1[0] * x1[0] + x1[1] * x1[1]) + (x1[2] * x1[2] + x1[3] * x1[3]); }
                ss += __shfl_xor(ss, 16); ss += __shfl_xor(ss, 32);
                if (fq == 0) P[r * 4 + wc] = ss; }
            asm volatile("" ::: "memory");
        }
        { const int srow = 16 * u.pm + fr; const size_t xo = (size_t)srow * DM + colx; const float* g = gate + (size_t)(NPROMPT + (srow >> 3)) * NMOD + colx; float ss = 0.f;
#pragma unroll
            for (int bj = 0; bj < 2; ++bj) { f32x4 b; const f32x4 gv = *(const f32x4*)(g + bj * HALF);
                { const float* shr = (const float*)xs + (size_t)(NPROMPT + (srow >> 3)) * NMOD + colx + bj * HALF; const u32x2v_ w = *(const u32x2v_*)(H + (size_t)MP * DM + xo + bj * HALF);
                    const f32x4 d = *(const f32x4*)((const float*)xp + colx + bj * HALF) * (*(const f32x4*)(shr + DM) + 1.0f);
                    b = (bf4(w.x, w.y) - *(const f32x4*)shr) * (f32x4){inv_scale(d[0]), inv_scale(d[1]), inv_scale(d[2]), inv_scale(d[3])} * rn[MP + srow]; }
                const f32x4 xn = b + gv * accx[bj]; accx[bj] = xn; ss += (xn[0] * xn[0] + xn[1] * xn[1]) + (xn[2] * xn[2] + xn[3] * xn[3]); }
            ss += __shfl_xor(ss, 16); ss += __shfl_xor(ss, 32);
            if (fq == 0) PX[fr * 8 + wid] = ss; }
        asm volatile("s_waitcnt lgkmcnt(0)" ::: "memory"); __builtin_amdgcn_s_barrier(); asm volatile("" ::: "memory");
        typedef __attribute__((address_space(1))) unsigned long long gu64_;
        gu64_* const gran = (gu64_*)xbuf + (size_t)u.pm * 272 * 4;
        if (tid < 272) { float tot;
            if (tid < 256) tot = (P[tid * 4 + 0] + P[tid * 4 + 1]) + (P[tid * 4 + 2] + P[tid * 4 + 3]);
            else { const PG8_LAS float* q = PX + (tid - 256) * 8; tot = ((q[0] + q[1]) + (q[2] + q[3])) + ((q[4] + q[5]) + (q[6] + q[7])); }
            __hip_atomic_store(gran + tid * 4 + u.pn, ((unsigned long long)epoch << 32) | __builtin_bit_cast(unsigned, tot), __ATOMIC_RELAXED, __HIP_MEMORY_SCOPE_AGENT); }
        typedef unsigned u32x2v __attribute__((ext_vector_type(2)));
        f32x4 ggm[2][2], svm[2][2], cvm[2][2];
        { const float* sh = msh + (size_t)(u.pm >> 3) * NMOD + col0;
#pragma unroll
            for (int bj = 0; bj < 2; ++bj)
#pragma unroll
                for (int n = 0; n < 2; ++n) { const int c = bj * HALF + n * 4; ggm[bj][n] = *(const f32x4*)(ng + col0 + c); svm[bj][n] = *(const f32x4*)(sh + c); cvm[bj][n] = *(const f32x4*)(sh + DM + c) + 1.0f; } }
        if (wid < 5) { const int rr = tid < 272 ? tid : 271; float pv[4];
            for (unsigned spins = 0;;) { bool ok = true;
#pragma unroll
                for (int k = 0; k < 4; ++k) { const unsigned long long x = __hip_atomic_load(gran + rr * 4 + k, __ATOMIC_RELAXED, __HIP_MEMORY_SCOPE_AGENT); pv[k] = __builtin_bit_cast(float, (unsigned)x); ok &= (unsigned)(x >> 32) == epoch; }
                if (__all(ok)) break;
                if (++spins > (1u << 20)) break;
                __builtin_amdgcn_s_sleep(1); }
            if (tid < 272) { const float ms = ((pv[0] + pv[1]) + (pv[2] + pv[3])) * (1.0f / DM) + EPS, rs = 1.0f / sqrtf(ms); S[tid] = rs;
                if (u.pn == 0 && !fin) rn[tid < 256 ? u.pm * BM + tid : MP + 16 * u.pm + (tid - 256)] = ms * rs; } }
        asm volatile("s_waitcnt lgkmcnt(0)" ::: "memory"); __builtin_amdgcn_s_barrier(); asm volatile("" ::: "memory");
#pragma unroll
        for (int ai = 0; ai < 2; ++ai)
#pragma unroll
            for (int m = 0; m < 4; ++m) { const int r = ai * HALF + wr * 64 + m * 16 + fr, row = u.pm * BM + r; const float rstd = S[r];
                float* dst = (float*)out + (size_t)row * DM + col0; bf16_t* hp = H + (size_t)row * DM + col0;
#pragma unroll
                for (int bj = 0; bj < 2; ++bj) { const f32x4 x0 = acc[ai][bj][m][0], x1 = acc[ai][bj][m][1];
                    if (fin) { *(f32x4*)(dst + bj * HALF) = x0 * rstd * ggm[bj][0]; *(f32x4*)(dst + bj * HALF + 4) = x1 * rstd * ggm[bj][1]; }
                    else { const f32x4 h0 = x0 * rstd * ggm[bj][0] * cvm[bj][0] + svm[bj][0], h1 = x1 * rstd * ggm[bj][1] * cvm[bj][1] + svm[bj][1];
                        *(u32x4*)(hp + bj * HALF) = (u32x4){cvt_pk_bf16(h0[0], h0[1]), cvt_pk_bf16(h0[2], h0[3]), cvt_pk_bf16(h1[0], h1[1]), cvt_pk_bf16(h1[2], h1[3])}; } } }
        { const int srow = 16 * u.pm + fr; const float rstd = S[256 + fr];
            const float* sh = msh + (size_t)(NPROMPT + (srow >> 3)) * NMOD + colx; float* dst = (float*)out + (size_t)(MP + srow) * DM + colx; bf16_t* hp = H + (size_t)(MP + srow) * DM + colx;
#pragma unroll
            for (int bj = 0; bj < 2; ++bj) { const int c = bj * HALF; const f32x4 xn = accx[bj]; const f32x4 gg = *(const f32x4*)(ng + colx + c);
                if (fin) *(f32x4*)(dst + c) = xn * rstd * gg;
                else { const f32x4 sv = *(const f32x4*)(sh + c), cv = *(const f32x4*)(sh + DM + c); const f32x4 h = xn * rstd * gg * (cv + 1.0f) + sv;
                    *(u32x2v*)(hp + c) = (u32x2v){cvt_pk_bf16(h[0], h[1]), cvt_pk_bf16(h[2], h[3])}; } } }
    }
};
struct EpiAny {
    static constexpr bool AFTER_DRAIN = false;
    int kind; bool perm; int ldc;
    void *p0, *p1, *p2; const float *f0, *f1, *f2; float* f3; const float *f4, *f5;
    __device__ __forceinline__ void fused(f32x4 (&acc)[2][2][4][2], f32x4 (&accx)[2], const Unit& u, int wr, int wc, int fr, int fq, PG8_LAS unsigned char* lds, int wid, int lane) const {
        EpiResidNorm e{(const void*)f0, (const void*)f1, (void*)f3, f2, (bf16_t*)p0, f4, f5, (float*)p1, (unsigned*)p2, (ldc & 1) != 0, (ldc & 2) != 0, (float*)p1 + (5u << 17), (unsigned)(ldc >> 8) + 1u};
        e.fused(acc, accx, u, wr, wc, fr, fq, lds, wid, lane);
    }
    __device__ __forceinline__ void operator()(const f32x4 (&acc)[2][2][4][2], const f32x4 (&accx)[2], const Unit& u, int wr, int wc, int fr, int fq) const {
        switch (kind) {
            case 0: { EpiF32 e{(float*)p0, ldc, f0}; e(acc, accx, u, wr, wc, fr, fq); } break;
            case 1: { EpiEvenIn e{(bf16_t*)p0, (bf16_t*)p1, (bf16_t*)p2}; e(acc, accx, u, wr, wc, fr, fq); } break;
            case 2: { EpiOddIn e{(bf16_t*)p0, (bf16_t*)p1, f0, f3}; e(acc, accx, u, wr, wc, fr, fq); } break;
            case 3: break;
            case 5: { EpiBBconv e{(const bf16_t*)p1, (bf16_t*)p0, f0, f1}; e(acc, accx, u, wr, wc, fr, fq); } break;
            default: { EpiRelu2 e{(bf16_t*)p0, ldc}; e(acc, accx, u, wr, wc, fr, fq); } break;
        }
    }
};

template <class Epi, class Sched, bool ALIGN_EPI = false, bool SP2 = true>
__device__ __forceinline__ void gemm_phase(PG8_LAS unsigned char* lds, const Gemm g, const Sched& S, const Epi& E) {
    static_assert(SP2, "only the two-super-phase loop is kept");
    int tid_ = threadIdx.x; asm volatile("" : "+v"(tid_));
    const int tid = tid_, wid = __builtin_amdgcn_readfirstlane(tid >> 6), lane = tid & 63, wr = wid >> 2, wc = wid & 3, fr = lane & 15, fq = lane >> 4;
    const int K = g.K, nt = K / BK;
    unsigned voffA, voffB;
    { int R, C; stage_rc(tid * 16, R, C); const int Rb = E.perm ? ((R & ~31) + perm32(R & 31)) : R;
        voffA = (unsigned)(R * K + C) * 2u; voffB = (unsigned)(Rb * K + C) * 2u; }
    const size_t rstep64 = (size_t)64 * K * 2;
    const unsigned voffX = (unsigned)((tid >> 5) * K) * 2u + (unsigned)((((tid & 31) >> 2) ^ ((tid >> 6) & 7)) * 16 + (tid & 3) * 4);
    const size_t kstep = (size_t)(BK * 2);
    const size_t hstep = (size_t)HALF * K * 2;
    const size_t tstep = 2 * hstep;
    const size_t xstep = (size_t)16 * K * 2;
    const unsigned ldsw = (unsigned)wid * 1024u;
    const unsigned ldswx = (unsigned)wid * 256u;
    const int aoff = lds_byte(wr * 64 + fr, fq * 8), boff = lds_byte(wc * 32 + fr, fq * 8), xoff = fr * 128 + ((fq ^ (fr >> 1)) << 4);
#define PG8_SA(b, h) (((b) * 2 + (h)) * HTB)
#define PG8_SB(b, h) ((4 + (b) * 2 + (h)) * HTB)
#define PG8_SX(b) (STAGE_BYTES + (b) * 2048)
#define PG8_STAGE(bufoff, gbase, voff) do { _Pragma("unroll") for (int _i = 0; _i < 2; ++_i) { const char* _p = (const char*)(gbase) + (size_t)_i * rstep64; asm volatile("" : "+s"(_p)); \
        __builtin_amdgcn_global_load_lds((const unsigned*)(_p + (voff)), (PG8_LAS unsigned*)(lds + (bufoff) + ldsw + _i * 8192), 16, 0, 0); } } while (0)
#define PG8_STAGEX(b, gbase) do { const char* _p = (const char*)(gbase); asm volatile("" : "+s"(_p)); \
        __builtin_amdgcn_global_load_lds((const unsigned*)(_p + voffX), (PG8_LAS unsigned*)(lds + PG8_SX(b) + ldswx), 4, 0, 0); } while (0)
#define PG8_LDA(dst, b, h) do { _Pragma("unroll") for (int m = 0; m < 4; ++m) _Pragma("unroll") for (int k = 0; k < 2; ++k) dst[m][k] = *(const PG8_LAS bf16x8*)(lds + PG8_SA(b, h) + aoff + m * 2048 + k * 1024); } while (0)
#define PG8_LDB(dst, b, h) do { _Pragma("unroll") for (int n = 0; n < 2; ++n) _Pragma("unroll") for (int k = 0; k < 2; ++k) dst[n][k] = *(const PG8_LAS bf16x8*)(lds + PG8_SB(b, h) + boff + n * 2048 + k * 1024); } while (0)
#define PG8_LDX(dst, b) do { _Pragma("unroll") for (int k = 0; k < 2; ++k) dst[k] = *(const PG8_LAS bf16x8*)(lds + PG8_SX(b) + (xoff ^ (k * 64))); } while (0)
#define PG8_MMA(ai, bj, At, Bt) do { __builtin_amdgcn_s_setprio(1); _Pragma("unroll") for (int m = 0; m < 4; ++m) _Pragma("unroll") for (int n = 0; n < 2; ++n) _Pragma("unroll") for (int k = 0; k < 2; ++k) \
        acc[ai][bj][m][n] = __builtin_amdgcn_mfma_f32_16x16x32_bf16(Bt[n][k], At[m][k], acc[ai][bj][m][n], 0, 0, 0); __builtin_amdgcn_s_setprio(0); } while (0)
#define PG8_MMAX(Xt) do { if (wr == 0) { _Pragma("unroll") for (int k = 0; k < 2; ++k) { accx[0] = __builtin_amdgcn_mfma_f32_16x16x32_bf16(B0[0][k], Xt[k], accx[0], 0, 0, 0); accx[1] = __builtin_amdgcn_mfma_f32_16x16x32_bf16(B1[0][k], Xt[k], accx[1], 0, 0, 0); } } \
        else { _Pragma("unroll") for (int k = 0; k < 2; ++k) { accx[0] = __builtin_amdgcn_mfma_f32_16x16x32_bf16(B0[1][k], Xt[k], accx[0], 0, 0, 0); accx[1] = __builtin_amdgcn_mfma_f32_16x16x32_bf16(B1[1][k], Xt[k], accx[1], 0, 0, 0); } } } while (0)
#define PG8_WAIT_V(n) asm volatile("s_waitcnt vmcnt(" #n ")" ::: "memory")
#define PG8_WAIT_L(n) asm volatile("s_waitcnt lgkmcnt(" #n ")" ::: "memory")
#define PG8_BAR __builtin_amdgcn_s_barrier()
#define PG8_SCHED __builtin_amdgcn_sched_barrier(0)
    Unit cur, nxt; int ui = 0;
    if (!S.next(0, cur)) return;
    f32x4 acc[2][2][4][2]; f32x4 accx[2];
#pragma unroll
    for (int a = 0; a < 2; ++a)
#pragma unroll
        for (int b = 0; b < 2; ++b)
#pragma unroll
            for (int m = 0; m < 4; ++m)
#pragma unroll
                for (int n = 0; n < 2; ++n) acc[a][b][m][n] = (f32x4){0.f, 0.f, 0.f, 0.f};
    accx[0] = (f32x4){0.f, 0.f, 0.f, 0.f}; accx[1] = (f32x4){0.f, 0.f, 0.f, 0.f};
    bf16x8 At[4][2], B0[2][2], B1[2][2], Xt[2];
    const char* cA = (const char*)g.A + (size_t)cur.pm * tstep; const char* cB = (const char*)g.Bt + (size_t)cur.pn * tstep; const char* cX = (const char*)g.AX + (size_t)cur.pm * xstep;
    S.a_ready(cur);
    PG8_STAGE(PG8_SB(0, 0), cB, voffB); PG8_STAGE(PG8_SB(0, 1), cB + hstep, voffB); PG8_STAGE(PG8_SA(0, 0), cA, voffA); PG8_STAGE(PG8_SA(0, 1), cA + hstep, voffA); PG8_STAGEX(0, cX);
    if (wr == 1) PG8_BAR;
    PG8_WAIT_V(3); PG8_BAR;
    PG8_STAGE(PG8_SB(1, 0), cB + kstep, voffB); PG8_STAGE(PG8_SA(1, 0), cA + kstep, voffA); PG8_STAGE(PG8_SB(1, 1), cB + hstep + kstep, voffB);
    PG8_WAIT_V(6); PG8_BAR;
    for (;;) {
        const bool has_next = S.next(ui + 1, nxt);
        const char* nA = has_next ? (const char*)g.A + (size_t)nxt.pm * tstep : cA; const char* nB = has_next ? (const char*)g.Bt + (size_t)nxt.pn * tstep : cB;
        const char* nX = has_next ? (const char*)g.AX + (size_t)nxt.pm * xstep : cX;
        for (int t = 0; t < nt; t += 2) {
            const bool last = (t == nt - 2);
            const bool relax = (t == 0) && (ui > 0) && (E.kind == 4);
            const char* a1 = cA + (size_t)(t + 1) * kstep; const char* x1 = cX + (size_t)(t + 1) * kstep;
            const char* a2 = last ? nA : cA + (size_t)(t + 2) * kstep; const char* b2 = last ? nB : cB + (size_t)(t + 2) * kstep;
            const char* x2 = last ? nX : cX + (size_t)(t + 2) * kstep;
            const char* a3 = a2 + kstep; const char* b3 = b2 + kstep;
            if (last && has_next) S.a_ready(nxt);
            PG8_LDB(B0, 0, 0); PG8_LDB(B1, 0, 1); PG8_SCHED; PG8_LDA(At, 0, 0); PG8_STAGE(PG8_SA(1, 1), a1 + hstep, voffA); PG8_STAGEX(1, x1);
            if (relax) PG8_WAIT_V(27); else PG8_WAIT_V(9);
            PG8_WAIT_L(0); PG8_BAR; PG8_MMA(0, 0, At, B0); PG8_MMA(0, 1, At, B1); PG8_BAR; PG8_SCHED;
            PG8_LDA(At, 0, 1); PG8_LDX(Xt, 0); PG8_STAGE(PG8_SB(0, 0), b2, voffB); PG8_STAGE(PG8_SB(0, 1), b2 + hstep, voffB); PG8_STAGE(PG8_SA(0, 0), a2, voffA);
            if (relax) PG8_WAIT_V(27); else PG8_WAIT_V(9);
            PG8_WAIT_L(0); PG8_BAR; PG8_MMA(1, 0, At, B0); PG8_MMA(1, 1, At, B1); PG8_MMAX(Xt); PG8_BAR; PG8_SCHED;
            PG8_LDB(B0, 1, 0); PG8_LDB(B1, 1, 1); PG8_SCHED; PG8_LDA(At, 1, 0); PG8_STAGE(PG8_SA(0, 1), a2 + hstep, voffA); PG8_STAGEX(0, x2);
            PG8_WAIT_V(9); PG8_WAIT_L(0); PG8_BAR; PG8_MMA(0, 0, At, B0); PG8_MMA(0, 1, At, B1); PG8_BAR; PG8_SCHED;
            PG8_LDA(At, 1, 1); PG8_LDX(Xt, 1); PG8_STAGE(PG8_SB(1, 0), b3, voffB); PG8_STAGE(PG8_SB(1, 1), b3 + hstep, voffB); PG8_STAGE(PG8_SA(1, 0), a3, voffA);
            PG8_WAIT_V(9); PG8_WAIT_L(0); PG8_BAR; PG8_MMA(1, 0, At, B0); PG8_MMA(1, 1, At, B1); PG8_MMAX(Xt); PG8_BAR; PG8_SCHED;
        }
        if constexpr (ALIGN_EPI) { if (wr == 0) PG8_BAR; }
        { int fr_ = fr, fq_ = fq; asm volatile("" : "+v"(fr_), "+v"(fq_));
          if (E.kind != 3) E(acc, accx, cur, wr, wc, fr_, fq_); } S.done(cur);
        if (!has_next) break;
#pragma unroll
        for (int a = 0; a < 2; ++a)
#pragma unroll
            for (int b = 0; b < 2; ++b)
#pragma unroll
                for (int m = 0; m < 4; ++m)
#pragma unroll
                    for (int n = 0; n < 2; ++n) acc[a][b][m][n] = (f32x4){0.f, 0.f, 0.f, 0.f};
        accx[0] = (f32x4){0.f, 0.f, 0.f, 0.f}; accx[1] = (f32x4){0.f, 0.f, 0.f, 0.f};
        cur = nxt; cA = nA; cB = nB; cX = nX; ++ui;
        if constexpr (ALIGN_EPI) { if (wr == 1) PG8_BAR; }
    }
    PG8_WAIT_V(0);
    if constexpr (!ALIGN_EPI) { if (wr == 0) PG8_BAR; }
    PG8_BAR;
    if (E.kind == 3) { int fr_ = fr, fq_ = fq, ln_ = lane; asm volatile("" : "+v"(fr_), "+v"(fq_), "+v"(ln_)); E.fused(acc, accx, cur, wr, wc, fr_, fq_, lds, wid, ln_); }
#undef PG8_SA
#undef PG8_SB
#undef PG8_SX
#undef PG8_STAGE
#undef PG8_STAGEX
#undef PG8_LDA
#undef PG8_LDB
#undef PG8_LDX
#undef PG8_MMA
#undef PG8_MMAX
#undef PG8_WAIT_V
#undef PG8_WAIT_L
#undef PG8_BAR
#undef PG8_SCHED
}
}
#ifndef PG8_SP2
#define PG8_SP2 true
#endif
#ifndef PG8_ALIGN
#define PG8_ALIGN true
#endif

constexpr int NWAVES = 8;
constexpr int N_PHASES = 23;

constexpr size_t OUT_Y = 0;
constexpr size_t OUT_CA_P = (size_t)MT * DM;
constexpr size_t OUT_CA_S = OUT_CA_P + 2 * 8 * 30 * 512;
constexpr size_t OUT_CB_P = OUT_CA_S + 2 * 128 * 30 * 512;
constexpr size_t OUT_CB_S = OUT_CB_P + 2 * 8 * 2 * 512;
constexpr size_t OUT_CV_P = OUT_CB_S + 2 * 128 * 2 * 512;
constexpr size_t OUT_CV_S = OUT_CV_P + 2 * 8 * 128 * 1024;
constexpr size_t OUT_END = OUT_CV_S + 2 * 128 * 8 * 1024;
static_assert(OUT_END == 26476544, "d_out map");

constexpr size_t MiB = 1u << 20;
constexpr size_t WS_CTL = 0, CTL_ZERO_BYTES = 32 * 1024;
constexpr size_t WS_WINAB = 2 * MiB;
constexpr size_t WS_WOUTAB = 12 * MiB;
constexpr size_t WS_WINC = 16 * MiB;
constexpr size_t WS_WOUTC = 24 * MiB;
constexpr size_t WS_WFF1 = 28 * MiB;
constexpr size_t WS_WFF2 = 60 * MiB;
constexpr size_t WS_WADA = 92 * MiB;
constexpr size_t WS_CACT = 140 * MiB;
constexpr size_t WS_MOD = 141 * MiB;
constexpr size_t WS_STAT = 165 * MiB;
constexpr size_t WS_H = 168 * MiB;
constexpr size_t WS_BIG = 202 * MiB;
constexpr size_t WS_XBUF = 338 * MiB;
constexpr size_t WS_XB = 341 * MiB;
constexpr size_t WS_END = 375 * MiB;
constexpr size_t BIG_AG = 0, BIG_BX = 17 * MiB, BIG_BB = 34 * MiB, BIG_AB = 51 * MiB;
constexpr size_t BIG_U = 0, BIG_V = 34 * MiB, BIG_US = 68 * MiB;
static_assert((size_t)MT * DFF * 2 == 136 * MiB && (size_t)MT * DM * 2 == 34 * MiB && (size_t)MT * 512 * 2 == 17 * MiB, "sizes");
constexpr int CW_BAR = 1024;
constexpr int CW_SEAM = 8192;
static_assert((CW_BAR + 3456) * 4 <= (int)CTL_ZERO_BYTES, "barrier words inside the memset region");

constexpr int RING_OFF = 0, RING_BYTES = 131072;
constexpr int SLAB_BYTES = 4096;
constexpr int LDSCTL_OFF = RING_BYTES + SLAB_BYTES, MISC_OFF = LDSCTL_OFF + 320;
constexpr int LDS_BYTES = 147456;

#define GAS __attribute__((address_space(1)))
#define LAS __attribute__((address_space(3)))
typedef unsigned short bf16;
typedef unsigned v4u __attribute__((ext_vector_type(4)));
typedef unsigned v2u __attribute__((ext_vector_type(2)));
typedef float f32x4 __attribute__((ext_vector_type(4)));
typedef float f32x2 __attribute__((ext_vector_type(2)));
typedef short bf16x8 __attribute__((ext_vector_type(8)));
typedef GAS unsigned gu32;
#define RLX_AGENT __ATOMIC_RELAXED, __HIP_MEMORY_SCOPE_AGENT
#define LDS_WAIT() asm volatile("s_waitcnt lgkmcnt(0)" ::: "memory")
#define VM_WAIT() asm volatile("s_waitcnt vmcnt(0)" ::: "memory")
__device__ __forceinline__ unsigned f2bf(float f) { unsigned u = __builtin_bit_cast(unsigned, f); return (u + 0x7fffu + ((u >> 16) & 1u)) >> 16; }
__device__ __forceinline__ unsigned pk2(float lo, float hi) { return pg8::cvt_pk_bf16(lo, hi); }
__device__ __forceinline__ float bf2f(unsigned short b) { return __builtin_bit_cast(float, (unsigned)b << 16); }
__device__ __forceinline__ float bflo(unsigned w) { return __builtin_bit_cast(float, w << 16); }
__device__ __forceinline__ float bfhi(unsigned w) { return __builtin_bit_cast(float, w & 0xffff0000u); }
__device__ __forceinline__ float silu_f(float x) { return x * __builtin_amdgcn_rcpf(1.0f + __expf(-x)); }

#define XB_TMO      128
#define XB_XCNT(j)  (256  + 64 * (j))
#define XB_XSUB(j)  (1280 + 64 * (j))
#define XB_XGEN(j)  (2304 + 64 * (j))
#define XB_TOP      3328
#define XB_TOPGEN   3392
#define XCD_BAR_WORDS 3456
#define XB_SPIN_CAP (1u << 18)

__device__ __forceinline__ unsigned xb_ld(unsigned* p)              { return __hip_atomic_load(p, __ATOMIC_RELAXED, __HIP_MEMORY_SCOPE_AGENT); }
__device__ __forceinline__ unsigned xb_add(unsigned* p, unsigned v) { return __hip_atomic_fetch_add(p, v, __ATOMIC_RELAXED, __HIP_MEMORY_SCOPE_AGENT); }
__device__ __forceinline__ unsigned xb_xcc_id() { return (unsigned)__builtin_amdgcn_s_getreg((3 << 11) | 20) & 0xFu; }
#define XB_SPIN(cond, bar) do { unsigned _sp = 0; while (cond) { __builtin_amdgcn_s_sleep(1); \
    if ((++_sp & 255u) == 0u) { if (xb_ld(&(bar)[XB_TMO])) break; if (_sp > XB_SPIN_CAP) { atomicAdd(&(bar)[XB_TMO], 1u); break; } } } } while (0)

struct XcdBarrier {
    unsigned* bar; unsigned x;
    volatile LAS unsigned* st;
};

__device__ __forceinline__ XcdBarrier xcd_barrier_post(unsigned* bar, volatile LAS unsigned* st) {
    XcdBarrier b; b.bar = bar; b.x = xb_xcc_id(); b.st = st;
    if (threadIdx.x == 0) (void)xb_add(&bar[XB_XCNT(b.x)], 1u);
    return b;
}
__device__ __forceinline__ void xcd_barrier_complete(unsigned* bar, unsigned x, unsigned& nloc, unsigned& nx) {
    const unsigned G = gridDim.x * gridDim.y * gridDim.z;
    unsigned sum, cnt, mine, sp = 0u;
    for (;;) {
        sum = 0u; cnt = 0u; mine = 0u;
#pragma unroll
        for (unsigned j = 0; j < 16; ++j) { const unsigned c = xb_ld(&bar[XB_XCNT(j)]); sum += c; cnt += (c > 0u) ? 1u : 0u; mine = (j == x) ? c : mine; }
        if (sum == G) break;
        __builtin_amdgcn_s_sleep(1);
        if ((++sp & 255u) == 0u) { if (xb_ld(&bar[XB_TMO])) break; if (sp > XB_SPIN_CAP) { atomicAdd(&bar[XB_TMO], 1u); break; } }
    }
    nloc = mine > 0u ? mine : 1u; nx = cnt > 0u ? cnt : 1u;
}

__device__ __forceinline__ void xcd_barrier(const XcdBarrier& b) {
    asm volatile("s_waitcnt vmcnt(0)" ::: "memory");
    __syncthreads();
    if (threadIdx.x == 0) {
        unsigned* bar = b.bar;
        __builtin_amdgcn_s_waitcnt(0);
        unsigned nloc = b.st[0], nx = b.st[1];
        if (nloc == 0u) { xcd_barrier_complete(bar, b.x, nloc, nx); b.st[0] = nloc; b.st[1] = nx; }
        const unsigned old = xb_add(&bar[XB_XSUB(b.x)], 1u);
        const unsigned gen = old / nloc;
        if (old + 1u == (gen + 1u) * nloc) {
            __builtin_amdgcn_fence(__ATOMIC_RELEASE, "agent");
            asm volatile("s_waitcnt vmcnt(0)" ::: "memory");
            const unsigned og = xb_add(&bar[XB_TOP], 1u);
            const unsigned tg = og / nx;
            if (og + 1u == (tg + 1u) * nx) xb_add(&bar[XB_TOPGEN], 1u);
            else XB_SPIN(xb_ld(&bar[XB_TOPGEN]) == tg, bar);
            __builtin_amdgcn_fence(__ATOMIC_ACQUIRE, "agent");
            xb_add(&bar[XB_XGEN(b.x)], 1u);
            asm volatile("s_waitcnt vmcnt(0)" ::: "memory");
        } else {
            XB_SPIN(xb_ld(&bar[XB_XGEN(b.x)]) == gen, bar);
            __builtin_amdgcn_fence(__ATOMIC_ACQUIRE, "agent");
            asm volatile("s_waitcnt vmcnt(0)" ::: "memory");
        }
    }
    __syncthreads();
}
struct Args { const float* in[26]; float* out; unsigned char* ws; int ph_lo, ph_hi, li, pad; };
#define INP(i) (args.in[(i) + F.z])
struct Frame {
    LAS unsigned char* lds;
    volatile LAS unsigned* MISC;
    gu32* ctl;
    int tid, lane, wave, G, bid;
    int z;
    float* out;
    unsigned char* ws;
};
__device__ __forceinline__ float wave_sum(float v, int lane) {
    (void)lane;
#pragma unroll
    for (int o = 1; o < 64; o <<= 1) v += __shfl_xor(v, o);
    return v;
}

__device__ __forceinline__ void p0_transpose_item(const float* W, int K, int N, bf16* WT, int k0, int n0, int drow0, LAS float* scr, int lane) {
    f32x4 v[8];
#pragma unroll
    for (int i = 0; i < 8; ++i) { const int q = lane + 64 * i; v[i] = __builtin_nontemporal_load((const f32x4*)(W + (size_t)(k0 + (q >> 3)) * N + n0 + 4 * (q & 7))); }
#pragma unroll
    for (int i = 0; i < 8; ++i) { const int q = lane + 64 * i; LAS float* d = scr + (q >> 3) * 33 + 4 * (q & 7); d[0] = v[i].x; d[1] = v[i].y; d[2] = v[i].z; d[3] = v[i].w; }
    LDS_WAIT(); asm volatile("" ::: "memory");
    const int c = lane & 7;
#pragma unroll
    for (int j = 0; j < 4; ++j) { const int n = (lane >> 3) + 8 * j; const LAS float* s = scr + (8 * c) * 33 + n;
        v4u o; o.x = pk2(s[0 * 33], s[1 * 33]); o.y = pk2(s[2 * 33], s[3 * 33]); o.z = pk2(s[4 * 33], s[5 * 33]); o.w = pk2(s[6 * 33], s[7 * 33]);
        *(GAS v4u*)(WT + (size_t)(drow0 + n) * K + k0 + 8 * c) = o; }
    LDS_WAIT(); asm volatile("" ::: "memory");
}
__device__ __forceinline__ int even_in_row(int c) {
    const int seg = c >> 9, r = c & 511, q = r >> 7, j = r & 127;
    if (seg == 0) return 256 * q + j;
    if (seg == 1) return 256 * q + 128 + j;
    if (seg == 2) return 1024 + 256 * q + j;
    if (seg == 4) return 1024 + 256 * q + 128 + j;
    return 2048 + r;
}
template <bool DEFERRED>
__device__ __forceinline__ void p0_items(Frame& F, const Args& args, int gw, int NGW) {
    LAS float* scr = (LAS float*)(F.lds + RING_OFF + F.wave * 16384);
    constexpr int I_INAB = 16 * 80, I_OUT = 16 * 32, I_INC = 16 * 64, I_FF1 = 16 * 128, I_FF2 = 64 * 32, I_ADA = 16 * 192;
    constexpr int T0 = 0, T1 = T0 + 2 * I_INAB, T2 = T1 + 2 * I_OUT, T3 = T2 + 2 * I_INC, T4 = T3 + 2 * I_OUT, T5 = T4 + 4 * I_FF1, T6 = T5 + 4 * I_FF2, T7 = T6 + 4 * I_ADA;
    constexpr int NDEF = T7 - 13 * 2048, D0 = T6 - NDEF;
    for (int i = gw; i < (DEFERRED ? NDEF : T7 - NDEF); i += NGW) {
        int it;
        if (DEFERRED) it = D0 + i;
        else { constexpr int NADA = T7 - T6, NFF1 = D0 - T4; it = i < NADA ? T6 + i : (i - NADA < NFF1 ? T4 + (i - NADA) : i - NADA - NFF1); }
        const float* W; bf16* WT; int K, N, r, per; bool perm = false;
        if (it < T1)      { r = it - T0; per = I_INAB; K = 1024; N = 2560; W = INP(6);  WT = (bf16*)(F.ws + WS_WINAB);  perm = true; }
        else if (it < T2) { r = it - T1; per = I_OUT;  K = 1024; N = 1024; W = INP(12); WT = (bf16*)(F.ws + WS_WOUTAB); }
        else if (it < T3) { r = it - T2; per = I_INC;  K = 1024; N = 2048; W = INP(13); WT = (bf16*)(F.ws + WS_WINC); }
        else if (it < T4) { r = it - T3; per = I_OUT;  K = 1024; N = 1024; W = INP(19); WT = (bf16*)(F.ws + WS_WOUTC); }
        else if (it < T5) { r = it - T4; per = I_FF1;  K = 1024; N = 4096; W = INP(23); WT = (bf16*)(F.ws + WS_WFF1); }
        else if (it < T6) { r = it - T5; per = I_FF2;  K = 4096; N = 1024; W = INP(24); WT = (bf16*)(F.ws + WS_WFF2); }
        else              { r = it - T6; per = I_ADA;  K = 1024; N = 6144; W = INP(20); WT = (bf16*)(F.ws + WS_WADA); }
        const int layer = r / per, item = r % per; W += (size_t)layer * K * N; WT += (size_t)layer * K * N;
        const int nblk = N / 32, kb = item / nblk, nb = item % nblk, k0 = 64 * kb, n0 = 32 * nb;
        p0_transpose_item(W, K, N, WT, k0, n0, perm ? even_in_row(n0) : n0, scr, F.lane);
    }
}
__device__ __forceinline__ void p0_prologue(Frame& F, const Args& args) {
    { unsigned long long* gz = (unsigned long long*)(F.ws + WS_XBUF);
      for (int i = F.bid * (NWAVES * 64) + F.tid; i < 64 * 272 * 4; i += F.G * NWAVES * 64) gz[i] = 0ull; }
    p0_items<false>(F, args, F.bid * NWAVES + F.wave, F.G * NWAVES);
    bf16* cact = (bf16*)(F.ws + WS_CACT);
    for (int idx = F.bid * (NWAVES * 64) + F.tid; idx < 256 * DM; idx += F.G * NWAVES * 64) {
        const int row = idx >> 10, col = idx & 1023; float v = 0.f;
        if (row < NPROMPT) v = silu_f(INP(4)[row * DM + col]); else if (row < NSEQ) v = silu_f(INP(5)[(row - NPROMPT) * DM + col]);
        cact[idx] = (bf16)f2bf(v);
    }
}

__device__ __forceinline__ void norm_phase(Frame& F, const Args& args, const float* xp, const float* xs, const float* g, const float* msh, const float* msc, bf16* H) {
    const int gw = F.bid * NWAVES + F.wave, NGW = F.G * NWAVES;
    const GAS f32x4* g4 = (const GAS f32x4*)g + F.lane;
    for (int row = gw; row < MT; row += NGW) {
        const float* src = row < MP ? xp + (size_t)row * DM : xs + (size_t)(row - MP) * DM;
        const GAS f32x4* xr = (const GAS f32x4*)src + F.lane;
        const int sq = seq_of_row(row);
        const GAS f32x4* sh4 = (const GAS f32x4*)(msh + (size_t)sq * NMOD) + F.lane; const GAS f32x4* sc4 = (const GAS f32x4*)(msc + (size_t)sq * NMOD) + F.lane;
        f32x4 v[4]; float ss = 0.f;
#pragma unroll
        for (int j = 0; j < 4; ++j) { v[j] = __builtin_nontemporal_load(xr + (j >> 1) * 128 + F.lane + (j & 1)); ss += (v[j].x * v[j].x + v[j].y * v[j].y) + (v[j].z * v[j].z + v[j].w * v[j].w); }
        const float ms0 = wave_sum(ss, F.lane) * (1.0f / DM) + EPS, rstd = 1.0f / sqrtf(ms0);
        if (F.lane == 0) ((float*)(F.ws + WS_XBUF) + (5u << 17))[row] = ms0 * rstd;
        f32x4 h[4];
#pragma unroll
        for (int j = 0; j < 4; ++j) { const int o4 = (j >> 1) * 128 + F.lane + (j & 1); const f32x4 gg = g4[o4], sc = sc4[o4], sh = sh4[o4]; h[j] = v[j] * rstd * gg * (sc + 1.0f) + sh; }
        GAS v4u* o16 = (GAS v4u*)(H + (size_t)row * DM) + F.lane;
        o16[0] = (v4u){pk2(h[0].x, h[0].y), pk2(h[0].z, h[0].w), pk2(h[1].x, h[1].y), pk2(h[1].z, h[1].w)};
        o16[64] = (v4u){pk2(h[2].x, h[2].y), pk2(h[2].z, h[2].w), pk2(h[3].x, h[3].y), pk2(h[3].z, h[3].w)};
    }
}
__device__ __forceinline__ void final_norm_phase(Frame& F, const Args& args, float* x, const float* g) {
    const int gw = F.bid * NWAVES + F.wave, NGW = F.G * NWAVES;
    const GAS f32x4* g4 = (const GAS f32x4*)g + F.lane;
    for (int row = gw; row < MT; row += NGW) {
        GAS f32x4* xr = (GAS f32x4*)(x + (size_t)row * DM) + F.lane;
        f32x4 v[4]; float ss = 0.f;
#pragma unroll
        for (int j = 0; j < 4; ++j) { v[j] = xr[64 * j]; ss += (v[j].x * v[j].x + v[j].y * v[j].y) + (v[j].z * v[j].z + v[j].w * v[j].w); }
        const float rstd = 1.0f / sqrtf(wave_sum(ss, F.lane) * (1.0f / DM) + EPS);
#pragma unroll
        for (int j = 0; j < 4; ++j) xr[64 * j] = v[j] * rstd * g4[64 * j];
    }
}

template <int R, bool SAMPLE>
__device__ __forceinline__ void even_prep_item(Frame& F, const Args& args, int e, int rowbase, int t0, int sidx) {
    const bf16* AG = (const bf16*)(F.ws + WS_BIG + BIG_AG); const bf16* BX = (const bf16*)(F.ws + WS_BIG + BIG_BX);
    bf16* AB = (bf16*)(F.ws + WS_BIG + BIG_AB);
    LAS float* CO = (LAS float*)(F.lds + RING_OFF);
    const int c = F.tid;
    const f32x4 g0 = *(const f32x4*)(INP(9) + e * DA + 4 * F.lane), g1 = *(const f32x4*)(INP(9) + e * DA + 256 + 4 * F.lane);
    const f32x4 b0 = *(const f32x4*)(INP(10) + e * DA + 4 * F.lane), b1 = *(const f32x4*)(INP(10) + e * DA + 256 + 4 * F.lane);
    float bx[R + 2];
    if (SAMPLE) {
        const float* st = INP(3) + ((size_t)(e * NSAMP + sidx) * 2) * DA + c;
        bx[0] = st[0]; bx[1] = st[DA];
#pragma unroll
        for (int j = 0; j < R; ++j) bx[2 + j] = bf2f(BX[(size_t)(rowbase + j) * DA + c]);
    } else {
#pragma unroll
        for (int j = 0; j < R + 2; ++j) { const int t = t0 - 2 + j; const int rr = rowbase - 2 + j + (t < 0 ? -t : 0);
            const float v = bf2f(BX[(size_t)rr * DA + c]); bx[j] = t < 0 ? 0.f : v; }
    }
    {
        float in[R + 30];
        if (SAMPLE) {
            const float* st = INP(2) + ((size_t)(e * NSAMP + sidx) * 30) * DA + c;
#pragma unroll
            for (int j = 0; j < 30; ++j) in[j] = st[(size_t)j * DA];
#pragma unroll
            for (int j = 0; j < R; ++j) in[30 + j] = bf2f(AG[(size_t)(rowbase + j) * DA + c]);
        } else {
#pragma unroll
            for (int j = 0; j < R + 30; ++j) { const int t = t0 - 30 + j; const int rr = rowbase - 30 + j + (t < 0 ? -t : 0);
                const float v = bf2f(AG[(size_t)rr * DA + c]); in[j] = t < 0 ? 0.f : v; }
        }
        float w[31];
#pragma unroll
        for (int k = 0; k < 31; ++k) w[k] = INP(7)[(size_t)(e * 31 + k) * DA + c];
        const float bias = INP(8)[e * DA + c];
#pragma unroll
        for (int t = 0; t < R; ++t) { float a = bias;
#pragma unroll
            for (int k = 0; k < 31; ++k) a = fmaf(w[k], in[t + k], a);
            CO[t * DA + c] = a; }
        if (SAMPLE) { float* o = F.out + OUT_CA_S + ((size_t)(e * NSAMP + sidx) * 30) * DA + c;
#pragma unroll
            for (int j = 0; j < 30; ++j) o[(size_t)j * DA] = in[R + j];
        } else if (t0 == SEQ - R) { float* o = F.out + OUT_CA_P + ((size_t)(e * NPROMPT + sidx) * 30) * DA + c;
#pragma unroll
            for (int j = 0; j < 30; ++j) o[(size_t)j * DA] = in[R + j]; }
    }
    __syncthreads();
    {
        for (int t = F.wave; t < R; t += NWAVES) {
            const f32x4 x0 = *(const LAS f32x4*)(CO + t * DA + 4 * F.lane), x1 = *(const LAS f32x4*)(CO + t * DA + 256 + 4 * F.lane);
            const float mean = wave_sum((x0.x + x0.y) + (x0.z + x0.w) + (x1.x + x1.y) + (x1.z + x1.w), F.lane) * (1.0f / DA);
            const f32x4 d0 = x0 - mean, d1 = x1 - mean;
            const float var = wave_sum((d0.x * d0.x + d0.y * d0.y) + (d0.z * d0.z + d0.w * d0.w) + (d1.x * d1.x + d1.y * d1.y) + (d1.z * d1.z + d1.w * d1.w), F.lane) * (1.0f / DA);
            const float rstd = 1.0f / sqrtf(var + EPS);
            f32x4 y0 = d0 * rstd * g0 + b0, y1 = d1 * rstd * g1 + b1;
#pragma unroll
            for (int i = 0; i < 4; ++i) { y0[i] = silu_f(y0[i]); y1[i] = silu_f(y1[i]); }
            bf16* o = AB + (size_t)(rowbase + t) * DM + 4 * F.lane;
            *(GAS v2u*)o = (v2u){pk2(y0.x, y0.y), pk2(y0.z, y0.w)}; *(GAS v2u*)(o + 256) = (v2u){pk2(y1.x, y1.y), pk2(y1.z, y1.w)};
        }
    }
    {
        if (SAMPLE) { float* o = F.out + OUT_CB_S + ((size_t)(e * NSAMP + sidx) * 2) * DA + c; o[0] = bx[R]; o[DA] = bx[R + 1]; }
        else if (t0 == SEQ - R) { float* o = F.out + OUT_CB_P + ((size_t)(e * NPROMPT + sidx) * 2) * DA + c; o[0] = bx[R]; o[DA] = bx[R + 1]; }
    }
    __syncthreads();
}
struct EvTa { v4u ta[8]; };
__device__ __forceinline__ void even_item_load_ta(Frame& F, int tid, int rowbase, EvTa& L) {
    const bf16* AG = (const bf16*)(F.ws + WS_BIG + BIG_AG); const bool first = (rowbase & (SEQ - 1)) == 0;
#pragma unroll
    for (int i = 0; i < 8; ++i) { const int q = tid + 512 * i, j = q >> 6, ch = q & 63; const bool inr = q < 62 * 64, ok = inr && (!first || j >= 30);
        const v4u v = *(const GAS v4u*)(AG + (size_t)(rowbase + (ok ? j - 30 : 0)) * DA + 8 * ch); L.ta[i] = ok ? v : (v4u){0u, 0u, 0u, 0u}; }
}
__device__ __forceinline__ void even_prep_light(Frame& F, const Args& args, int e) {
    constexpr int RP = 32, NIP = MP / RP, LW0 = 128, LWN = 128;
    const bf16* BX = (const bf16*)(F.ws + WS_BIG + BIG_BX); bf16* AB = (bf16*)(F.ws + WS_BIG + BIG_AB);
    LAS unsigned char* TA = F.lds + RING_OFF; LAS float* CO = (LAS float*)(F.lds + RING_OFF + 62 * 1024);
    const int c = F.tid, cg = F.tid & 63, rb = F.tid >> 6;
    const int lw = F.bid - LW0;
    if (lw < 0) { if (F.bid < NSAMP) { const int sq = (F.bid & 7) * 16 + (F.bid >> 3); even_prep_item<DSEQ, true>(F, args, e, MP + sq * DSEQ, 0, sq); } return; }
    int it = 64 * (F.bid & 7) + (lw >> 3);
    {
        float w[31];
#pragma unroll
        for (int k = 0; k < 31; ++k) w[k] = INP(7)[(size_t)(e * 31 + k) * DA + c];
        const float bias = INP(8)[e * DA + c];
        const f32x4 g0 = *(const f32x4*)(INP(9) + e * DA + 8 * F.lane), g1 = *(const f32x4*)(INP(9) + e * DA + 8 * F.lane + 4);
        const f32x4 b0 = *(const f32x4*)(INP(10) + e * DA + 8 * F.lane), b1 = *(const f32x4*)(INP(10) + e * DA + 8 * F.lane + 4);
        EvTa cur;
#pragma unroll 1
        for (int k4 = 0; k4 < 4; ++k4, it += 16) {
            const int rowbase = it * RP, t0 = rowbase & (SEQ - 1), b = rowbase >> 11; const bool lastit = t0 == SEQ - 32;
            int tv = F.tid; asm volatile("" : "+v"(tv));
            const int c = tv, cg = tv & 63, rb = tv >> 6, ln = tv & 63;
            even_item_load_ta(F, tv, it * RP, cur);
#pragma unroll
            for (int i = 0; i < 8; ++i) { const int q = tv + 512 * i; if (q < 62 * 64) *(LAS v4u*)(TA + (q >> 6) * 1024 + (q & 63) * 16) = cur.ta[i]; }
            __syncthreads();
#pragma unroll
            for (int hh = 0; hh < 2; ++hh) {
                float in[46];
#pragma unroll
                for (int j = 0; j < 46; ++j) in[j] = bf2f(*(const LAS unsigned short*)(TA + (16 * hh + j) * 1024 + c * 2));
#pragma unroll
                for (int t = 0; t < 16; ++t) { float a = bias;
#pragma unroll
                    for (int k = 0; k < 31; ++k) a = fmaf(w[k], in[t + k], a);
                    CO[(16 * hh + t) * DA + c] = a; }
                if (hh == 1 && lastit) { float* o = F.out + OUT_CA_P + ((size_t)(e * NPROMPT + b) * 30) * DA + c;
#pragma unroll
                    for (int j = 0; j < 30; ++j) o[(size_t)j * DA] = in[16 + j]; }
            }
            __syncthreads();
#pragma unroll
            for (int tt = 0; tt < 4; ++tt) { const int t = F.wave + 8 * tt;
                const f32x4 x0 = *(const LAS f32x4*)(CO + t * DA + 8 * ln), x1 = *(const LAS f32x4*)(CO + t * DA + 8 * ln + 4);
                const float mean = wave_sum((x0.x + x0.y) + (x0.z + x0.w) + (x1.x + x1.y) + (x1.z + x1.w), ln) * (1.0f / DA);
                const f32x4 d0 = x0 - mean, d1 = x1 - mean;
                const float var = wave_sum((d0.x * d0.x + d0.y * d0.y) + (d0.z * d0.z + d0.w * d0.w) + (d1.x * d1.x + d1.y * d1.y) + (d1.z * d1.z + d1.w * d1.w), ln) * (1.0f / DA);
                const float rstd = 1.0f / sqrtf(var + EPS);
                f32x4 y0 = d0 * rstd * g0 + b0, y1 = d1 * rstd * g1 + b1;
#pragma unroll
                for (int i = 0; i < 4; ++i) { y0[i] = silu_f(y0[i]); y1[i] = silu_f(y1[i]); }
                *(GAS v4u*)(AB + (size_t)(rowbase + t) * DM + 8 * ln) = (v4u){pk2(y0.x, y0.y), pk2(y0.z, y0.w), pk2(y1.x, y1.y), pk2(y1.z, y1.w)};
            }
            if (lastit) {
                float* o = F.out + OUT_CB_P + ((size_t)(e * NPROMPT + b) * 2) * DA + c;
                o[0] = bf2f(BX[(size_t)(rowbase + 30) * DA + c]); o[DA] = bf2f(BX[(size_t)(rowbase + 31) * DA + c]); }
        }
        __syncthreads();
    }
}

constexpr int VT_PITCH = 272;
template <int NP>
__device__ __forceinline__ void row_stats(const float* st, float& mean, float& rstd) {
    float s1 = 0.f, s2 = 0.f;
#pragma unroll
    for (int p = 0; p < NP; ++p) { s1 += st[2 * p]; s2 += st[2 * p + 1]; }
    mean = s1 * (1.0f / DM); const float var = fmaxf(s2 * (1.0f / DM) - mean * mean, 0.f); rstd = 1.0f / sqrtf(var + EPS);
}
__device__ __forceinline__ int vt_f(int d) { return (d & 15) ^ (d >> 4); }
struct OdPre { v4u va[2], vb[2]; f32x4 ga, gb, ba, bb; f32x4 wsa[4], wsb[4]; v4u uu[4]; float bs; };
__device__ __forceinline__ void odd_item_load(Frame& F, const Args& args, int o, int it, OdPre& P) {
    const bf16* V = (const bf16*)(F.ws + WS_BIG + BIG_V); const bf16* U = (const bf16*)(F.ws + WS_BIG + BIG_U);
    const int ci = it >> 3, h = it & 7, R0 = ci * 128, tl = F.lane & 15, kq = F.lane >> 4, t = 16 * F.wave + tl;
#pragma unroll
    for (int i2 = 0; i2 < 2; ++i2) { const int q = F.tid + 512 * i2, cc = q & 15, rp = q >> 4, col = h * 128 + cc * 8;
        P.va[i2] = *(const GAS v4u*)(V + (size_t)(R0 + 2 * rp) * DM + col); P.vb[i2] = *(const GAS v4u*)(V + (size_t)(R0 + 2 * rp + 1) * DM + col); }
    { const int col = h * 128 + (F.tid & 15) * 8;
        P.ga = *(const f32x4*)(INP(15) + o * DM + col); P.gb = *(const f32x4*)(INP(15) + o * DM + col + 4); P.ba = *(const f32x4*)(INP(16) + o * DM + col); P.bb = *(const f32x4*)(INP(16) + o * DM + col + 4); }
    { const float* wrow = INP(17) + ((size_t)(o * 8 + h) * 128 + t) * 128 + 8 * kq;
#pragma unroll
        for (int kk = 0; kk < 4; ++kk) {
            if (32 * kk <= 16 * F.wave + 15) { P.wsa[kk] = *(const f32x4*)(wrow + 32 * kk); P.wsb[kk] = *(const f32x4*)(wrow + 32 * kk + 4); }
            else { P.wsa[kk] = (f32x4){0.f, 0.f, 0.f, 0.f}; P.wsb[kk] = P.wsa[kk]; } } }
#pragma unroll
    for (int p = 0; p < 4; ++p) P.uu[p] = *(const GAS v4u*)(U + (size_t)(R0 + t) * DM + h * 128 + 32 * p + 8 * kq);
    P.bs = INP(18)[(o * 8 + h) * 128 + t];
}
__device__ __forceinline__ void odd_prep_sample_item(Frame& F, const Args& args, int o, int s) {
    const bf16* U = (const bf16*)(F.ws + WS_BIG + BIG_U); const bf16* V = (const bf16*)(F.ws + WS_BIG + BIG_V); bf16* US = (bf16*)(F.ws + WS_BIG + BIG_US);
    const float* stat = (const float*)(F.ws + WS_STAT);
    LAS float* RS = (LAS float*)(F.lds + RING_OFF);
    const int R0 = MP + s * DSEQ;
    const int col = 2 * F.tid, h = col >> 7;
    const f32x2 g = *(const f32x2*)(INP(15) + o * DM + col), bb = *(const f32x2*)(INP(16) + o * DM + col);
    unsigned vw[DSEQ], uw[DSEQ];
#pragma unroll
    for (int t = 0; t < DSEQ; ++t) { vw[t] = *(const GAS unsigned*)(V + (size_t)(R0 + t) * DM + col); uw[t] = *(const GAS unsigned*)(U + (size_t)(R0 + t) * DM + col); }
    f32x4 wsv[DSEQ][2]; float bsv[DSEQ];
    { const float* ws = INP(17) + (size_t)(o * 8 + h) * 128 * 128; const float* bsp = INP(18) + (o * 8 + h) * 128;
#pragma unroll
        for (int t = 0; t < DSEQ; ++t) { wsv[t][0] = *(const f32x4*)(ws + t * 128); wsv[t][1] = *(const f32x4*)(ws + t * 128 + 4); bsv[t] = bsp[t]; } }
    if (F.tid < DSEQ) { float mean, rstd; row_stats<32>(stat + (size_t)MP * 32 + (size_t)(s * DSEQ + F.tid) * 64, mean, rstd); RS[2 * F.tid] = mean; RS[2 * F.tid + 1] = rstd; }
    __syncthreads();
    float vn[DSEQ][2];
#pragma unroll
    for (int t = 0; t < DSEQ; ++t) { const unsigned w = vw[t]; const float m = RS[2 * t], r = RS[2 * t + 1];
        vn[t][0] = (bflo(w) - m) * r * g.x + bb.x; vn[t][1] = (bfhi(w) - m) * r * g.y + bb.y;
        *(f32x2*)(F.out + OUT_CV_S + ((size_t)(o * NSAMP + s) * DSEQ + t) * DM + col) = (f32x2){vn[t][0], vn[t][1]}; }
#pragma unroll
    for (int t = 0; t < DSEQ; ++t) { float a0 = bsv[t], a1 = a0; const float wrow[8] = {wsv[t][0].x, wsv[t][0].y, wsv[t][0].z, wsv[t][0].w, wsv[t][1].x, wsv[t][1].y, wsv[t][1].z, wsv[t][1].w};
#pragma unroll
        for (int k = 0; k <= t; ++k) { const float w = wrow[k]; a0 = fmaf(w, vn[k][0], a0); a1 = fmaf(w, vn[k][1], a1); }
        const unsigned uu = uw[t];
        *(GAS unsigned*)(US + (size_t)(R0 + t) * DM + col) = pk2(bflo(uu) * a0, bfhi(uu) * a1); }
    __syncthreads();
}
__device__ __forceinline__ void odd_prep_phase(Frame& F, const Args& args, int o) {
    constexpr int NIP = (MP / 128) * 8, NJ = NIP / 256;
    const bf16* U = (const bf16*)(F.ws + WS_BIG + BIG_U); bf16* US = (bf16*)(F.ws + WS_BIG + BIG_US);
    LAS float* RSall = (LAS float*)(F.lds + RING_OFF + 65536);
    const int tl = F.lane & 15, kq = F.lane >> 4, t = 16 * F.wave + tl, c0 = F.bid;
    const int hh = (c0 >> 3) & 7, cbase = 16 * (c0 & 7) + (c0 >> 6);
    OdPre cur;
    {
        const int j = F.tid >> 7, r = F.tid & 127, row = (cbase + 4 * j) * 128 + r;
        const float* st = (const float*)(F.ws + WS_STAT) + (size_t)row * 32; float s1 = 0.f, s2 = 0.f;
#pragma unroll
        for (int i = 0; i < 8; ++i) { const f32x4 v = *(const f32x4*)(st + 4 * i); s1 += v.x + v.z; s2 += v.y + v.w; }
        const float mean = s1 * (1.0f / DM), var = fmaxf(s2 * (1.0f / DM) - mean * mean, 0.f); RSall[2 * F.tid] = mean; RSall[2 * F.tid + 1] = 1.0f / sqrtf(var + EPS);
    }
    __syncthreads();
#pragma unroll 1
    for (int j = 0; j < NJ; ++j) {
        const int ci = cbase + 4 * j, h = hh, it = ci * 8 + h, R0 = ci * 128, b = ci >> 4; const bool last = (ci & 15) == 15;
        odd_item_load(F, args, o, it, cur);
        LAS unsigned char* VT = F.lds + RING_OFF + (j & 1) * 32768;
        const LAS float* RS = RSall + j * 256;
#pragma unroll
        for (int i2 = 0; i2 < 2; ++i2) {
            const int q = F.tid + 512 * i2, cc = q & 15, rp = q >> 4, s0 = 2 * rp, col = h * 128 + cc * 8;
            const float m0 = RS[2 * s0], r0 = RS[2 * s0 + 1], m1 = RS[2 * s0 + 2], r1 = RS[2 * s0 + 3];
            float n0[8], n1[8];
            const float gv[8] = {cur.ga.x, cur.ga.y, cur.ga.z, cur.ga.w, cur.gb.x, cur.gb.y, cur.gb.z, cur.gb.w}, bv[8] = {cur.ba.x, cur.ba.y, cur.ba.z, cur.ba.w, cur.bb.x, cur.bb.y, cur.bb.z, cur.bb.w};
            const unsigned wav[4] = {cur.va[i2].x, cur.va[i2].y, cur.va[i2].z, cur.va[i2].w}, wbv[4] = {cur.vb[i2].x, cur.vb[i2].y, cur.vb[i2].z, cur.vb[i2].w};
#pragma unroll
            for (int i = 0; i < 4; ++i) {
                n0[2 * i] = (bflo(wav[i]) - m0) * r0 * gv[2 * i] + bv[2 * i]; n0[2 * i + 1] = (bfhi(wav[i]) - m0) * r0 * gv[2 * i + 1] + bv[2 * i + 1];
                n1[2 * i] = (bflo(wbv[i]) - m1) * r1 * gv[2 * i] + bv[2 * i]; n1[2 * i + 1] = (bfhi(wbv[i]) - m1) * r1 * gv[2 * i + 1] + bv[2 * i + 1];
            }
            if (last) { float* cv = F.out + OUT_CV_P + ((size_t)(o * NPROMPT + b) * 128 + s0) * DM + col;
                *(f32x4*)cv = (f32x4){n0[0], n0[1], n0[2], n0[3]}; *(f32x4*)(cv + 4) = (f32x4){n0[4], n0[5], n0[6], n0[7]};
                *(f32x4*)(cv + DM) = (f32x4){n1[0], n1[1], n1[2], n1[3]}; *(f32x4*)(cv + DM + 4) = (f32x4){n1[4], n1[5], n1[6], n1[7]}; }
#pragma unroll
            for (int i = 0; i < 8; ++i) { const int d = cc * 8 + i; *(LAS unsigned*)(VT + d * 256 + (((rp >> 2) ^ vt_f(d)) << 4) + ((rp & 3) << 2)) = pk2(n0[i], n1[i]); }
        }
        __syncthreads();
        const float bs = cur.bs;
        f32x4 acc[8];
#pragma unroll
        for (int n = 0; n < 8; ++n) acc[n] = (f32x4){0.f, 0.f, 0.f, 0.f};
#pragma unroll
        for (int kk = 0; kk < 4; ++kk) {
            if (32 * kk <= 16 * F.wave + 15) {
                const int s0 = 32 * kk + 8 * kq;
                float wv[8] = {cur.wsa[kk].x, cur.wsa[kk].y, cur.wsa[kk].z, cur.wsa[kk].w, cur.wsb[kk].x, cur.wsb[kk].y, cur.wsb[kk].z, cur.wsb[kk].w};
#pragma unroll
                for (int jj = 0; jj < 8; ++jj) wv[jj] = (s0 + jj <= t) ? wv[jj] : 0.f;
                v4u wp; wp.x = pk2(wv[0], wv[1]); wp.y = pk2(wv[2], wv[3]); wp.z = pk2(wv[4], wv[5]); wp.w = pk2(wv[6], wv[7]);
                const bf16x8 wf = __builtin_bit_cast(bf16x8, wp);
#pragma unroll
                for (int n = 0; n < 8; ++n) { const int d = 32 * (n >> 1) + 8 * (tl >> 2) + 4 * (n & 1) + (tl & 3);
                    const bf16x8 vf = *(const LAS bf16x8*)(VT + d * 256 + (((4 * kk + kq) ^ vt_f(d)) << 4));
                    acc[n] = __builtin_amdgcn_mfma_f32_16x16x32_bf16(vf, wf, acc[n], 0, 0, 0); }
            }
        }
#pragma unroll
        for (int p = 0; p < 4; ++p) { const size_t off = (size_t)(R0 + t) * DM + h * 128 + 32 * p + 8 * kq; const f32x4 a0 = acc[2 * p], a1 = acc[2 * p + 1]; const v4u w = cur.uu[p];
            *(GAS v4u*)(US + off) = (v4u){pk2(bflo(w.x) * (a0.x + bs), bfhi(w.x) * (a0.y + bs)), pk2(bflo(w.y) * (a0.z + bs), bfhi(w.y) * (a0.w + bs)),
                                          pk2(bflo(w.z) * (a1.x + bs), bfhi(w.z) * (a1.y + bs)), pk2(bflo(w.w) * (a1.z + bs), bfhi(w.w) * (a1.w + bs))}; }
    }
    __syncthreads();
    if (c0 < NSAMP) odd_prep_sample_item(F, args, o, (c0 & 7) * 16 + (c0 >> 3));
}

__global__ void __launch_bounds__(NWAVES * 64, 2) skel_fwd(Args args) {
    extern __shared__ __attribute__((aligned(16))) unsigned char lds[];
    Frame F;
    F.lds = (LAS unsigned char*)lds;
    F.MISC = (volatile LAS unsigned*)(F.lds + MISC_OFF);
    F.tid = threadIdx.x; F.lane = F.tid & 63; F.wave = __builtin_amdgcn_readfirstlane(F.tid >> 6);
    F.G = gridDim.x;
    F.z = 0; F.out = args.out; F.ws = args.ws;
    F.ctl = (gu32*)(args.ws + WS_CTL);
    for (int u = F.tid; u < (LDS_BYTES - LDSCTL_OFF) / 4; u += NWAVES * 64) ((LAS unsigned*)(F.lds + LDSCTL_OFF))[u] = 0u;
    __syncthreads();
    XcdBarrier bar; bar.bar = (unsigned*)(F.ctl + CW_BAR); bar.x = 0; bar.st = nullptr;
#if MK_ONE_LAUNCH
    bar = xcd_barrier_post((unsigned*)(F.ctl + CW_BAR), F.MISC + 8);
#endif
    const int lo = args.ph_lo, hi = args.ph_hi;
    bool repeated = false;
#pragma unroll 1
    for (int p = lo; p < hi; ++p) {
        { int z = 0; asm volatile("" : "+s"(z)); F.z = z; F.out = args.out + z; F.ws = args.ws + z;
          int t_ = threadIdx.x; asm volatile("" : "+v"(t_)); F.tid = t_; F.lane = t_ & 63; F.wave = __builtin_amdgcn_readfirstlane(t_ >> 6);
          int b_ = blockIdx.x; asm volatile("" : "+s"(b_)); F.bid = b_; }
        float* const X = F.out + OUT_Y;
        int kind = -1;
        pg8::Gemm g{nullptr, nullptr, nullptr, 0, 0, 0}; pg8::EpiAny E{0, false, 0, nullptr, nullptr, nullptr, nullptr, nullptr, nullptr, nullptr, nullptr, nullptr};
        bf16* const H = (bf16*)(F.ws + WS_H);
        if (p == 0) { p0_prologue(F, args); }
        else if (p == 1) {
            kind = 0; g = pg8::Gemm{(const bf16*)(F.ws + WS_CACT), (const bf16*)(F.ws + WS_WADA), (const bf16*)(F.ws + WS_CACT), 256, NMOD, DM};
            E.kind = 0; E.perm = false; E.ldc = NMOD; E.p0 = (void*)(F.ws + WS_MOD); E.f0 = INP(21);
        } else if (p == 2) {
            norm_phase(F, args, INP(0), INP(1), INP(22), (const float*)(F.ws + WS_MOD) + 0 * DM, (const float*)(F.ws + WS_MOD) + 1 * DM, H);
        } else {
            const int l = (p - 3) / 5, k = (p - 3) % 5, eo = l >> 1; const bool even = (l & 1) == 0;
            bf16* const XB = (bf16*)(F.ws + WS_XB);
            const float* xp = l == 0 ? INP(0) : (const float*)XB; const float* xs = l == 0 ? INP(1) : (const float*)(XB + (size_t)MP * DM);
            const float* modl = (const float*)(F.ws + WS_MOD) + (size_t)l * NMODL;
            if (k == 1) {
                if (even) {
                    kind = 5; g = pg8::Gemm{H, (const bf16*)(F.ws + WS_WINAB) + (size_t)eo * DIN_E * DM + (size_t)2048 * DM, H + (size_t)MP * DM, MP, 512, DM};
                    E.kind = 5; E.perm = true; E.p0 = (void*)(F.ws + WS_BIG + BIG_AB); E.p1 = (void*)(F.ws + WS_BIG + BIG_BX); E.f0 = INP(11) + (size_t)eo * 3 * DA; E.f1 = INP(3) + (size_t)eo * NSAMP * 2 * DA;
                } else odd_prep_phase(F, args, eo);
            }
            else if (k == 0) {
                if (even) { kind = 1; g = pg8::Gemm{H, (const bf16*)(F.ws + WS_WINAB) + (size_t)eo * DIN_E * DM, H + (size_t)MP * DM, MP, 2048, DM};
                    E.kind = 1; E.perm = true; E.p0 = (void*)(F.ws + WS_BIG + BIG_AG); E.p1 = (void*)(F.ws + WS_BIG + BIG_BX); E.p2 = (void*)(F.ws + WS_BIG + BIG_BB); }
                else { kind = 2; g = pg8::Gemm{H, (const bf16*)(F.ws + WS_WINC) + (size_t)eo * 2048 * DM, H + (size_t)MP * DM, MP, 2048, DM};
                    E.kind = 2; E.perm = true; E.p0 = (void*)(F.ws + WS_BIG + BIG_U); E.p1 = (void*)(F.ws + WS_BIG + BIG_V); E.f0 = INP(14) + (size_t)eo * 2048; E.f3 = (float*)(F.ws + WS_STAT); }
            } else if (k == 3) {
                kind = 4; g = pg8::Gemm{H, (const bf16*)(F.ws + WS_WFF1) + (size_t)l * DFF * DM, H + (size_t)MP * DM, MP, DFF, DM};
                E.kind = 4; E.perm = true; E.ldc = DFF; E.p0 = (void*)(F.ws + WS_BIG);
            } else {
                kind = 3; const int seam = 2 * l + (k == 4);
                if (k == 2) { const bf16* Amix = even ? (const bf16*)(F.ws + WS_BIG + BIG_AB) : (const bf16*)(F.ws + WS_BIG + BIG_US);
                    g = pg8::Gemm{Amix, (even ? (const bf16*)(F.ws + WS_WOUTAB) : (const bf16*)(F.ws + WS_WOUTC)) + (size_t)eo * DM * DM, Amix + (size_t)MP * DM, MP, DM, DM};
                    E.f0 = INP(22) + (size_t)seam * DM; E.f1 = modl; E.ldc = 0;
                    E.f2 = modl + 2 * DM; E.f4 = INP(22) + (size_t)(l * 2 + 1) * DM; E.f5 = modl + 3 * DM; }
                else { g = pg8::Gemm{(const bf16*)(F.ws + WS_BIG), (const bf16*)(F.ws + WS_WFF2) + (size_t)l * DM * DFF, (const bf16*)(F.ws + WS_BIG) + (size_t)MP * DFF, MP, DM, DFF};
                    E.f0 = INP(22) + (size_t)seam * DM; E.f1 = modl + 3 * DM; E.f2 = modl + 5 * DM;
                    if (l == 3) { E.ldc = 1; E.f4 = INP(25); E.f5 = modl; } else { E.f4 = INP(22) + (size_t)((l + 1) * 2 + 0) * DM; E.f5 = modl + NMODL; } }
                E.kind = 3; E.perm = true; E.f3 = X; E.p0 = (void*)H; E.ldc |= seam << 8;
                E.p1 = (void*)(F.ws + WS_XBUF); E.p2 = (void*)((unsigned*)(F.ws + WS_CTL) + CW_SEAM + seam * 64 * 64);
            }
        }
        if (kind >= 0) {
            pg8::StaticOrder S; S.init(g.M, g.N, F.G, F.bid);
            pg8::gemm_phase<pg8::EpiAny, pg8::StaticOrder, PG8_ALIGN, PG8_SP2>(F.lds + RING_OFF, g, S, E);
            if (kind == 0 && F.bid >= 96) {
                int t_ = threadIdx.x; asm volatile("" : "+v"(t_)); F.tid = t_; F.lane = t_ & 63; F.wave = __builtin_amdgcn_readfirstlane(t_ >> 6);
                p0_items<true>(F, args, (F.bid - 96) * NWAVES + F.wave, (F.G - 96) * NWAVES); }
            if (kind == 5) {
                int t_ = threadIdx.x; asm volatile("" : "+v"(t_)); F.tid = t_; F.lane = t_ & 63; F.wave = __builtin_amdgcn_readfirstlane(t_ >> 6);
                even_prep_light(F, args, ((p - 3) / 5) >> 1); }
        }
        if (p + 1 < hi) xcd_barrier(bar);
        if (REP_P >= 0 && p == REP_P && !repeated) { repeated = true; --p; }
    }
}

extern "C" void kernel_launch(void* const* d_in, const int* in_sizes, int n_in, void* d_out, int out_size, void* d_ws, size_t ws_size, hipStream_t stream) {
    static int grid = 0;
    if (grid == 0) {
        if (n_in != 26 || out_size != (int)OUT_END || ws_size < WS_END) { fprintf(stderr, "kernel_launch: unexpected shapes: n_in %d out %d ws %zu\n", n_in, out_size, ws_size); grid = -1; return; }
        int dev = 0, cus = 0, per_cu = 0;
        if (hipGetDevice(&dev) != hipSuccess || hipDeviceGetAttribute(&cus, hipDeviceAttributeMultiprocessorCount, dev) != hipSuccess) { grid = -1; return; }
        if (hipFuncSetAttribute((const void*)skel_fwd, hipFuncAttributeMaxDynamicSharedMemorySize, LDS_BYTES) != hipSuccess) { fprintf(stderr, "kernel_launch: hipFuncSetAttribute failed\n"); grid = -1; return; }
        if (hipOccupancyMaxActiveBlocksPerMultiprocessor(&per_cu, (const void*)skel_fwd, NWAVES * 64, LDS_BYTES) != hipSuccess || per_cu < 1) { fprintf(stderr, "kernel_launch: occupancy query says %d workgroups per CU\n", per_cu); (void)hipGetLastError(); grid = -1; return; }
        if (cus != 256) { fprintf(stderr, "kernel_launch: built for a 256-CU device (the fused norm epilogues need one 272x256 unit per workgroup); this device has %d CUs\n", cus); grid = -1; return; }
        grid = cus;
    }
    if (grid < 0) return;
    (void)hipMemsetAsync((char*)d_ws + WS_CTL, 0, CTL_ZERO_BYTES, stream);
    Args a{};
    for (int i = 0; i < 26; ++i) a.in[i] = (const float*)d_in[i];
    a.out = (float*)d_out; a.ws = (unsigned char*)d_ws;
#if MK_ONE_LAUNCH
    a.ph_lo = 0; a.ph_hi = N_PHASES; a.li = 0;
    hipLaunchKernelGGL(skel_fwd, dim3(grid), dim3(NWAVES * 64), LDS_BYTES, stream, a);
#else
    for (int p = 0; p < N_PHASES; ++p) { a.ph_lo = p; a.ph_hi = p + 1; a.li = p; hipLaunchKernelGGL(skel_fwd, dim3(grid), dim3(NWAVES * 64), LDS_BYTES, stream, a); }
#endif
}
```
